# Optimizing an MI355X kernel written in HIP

```python
import jax, jax.numpy as jnp
from jax import lax
import numpy as np

D_MODEL = 2048
BATCH = 2
SEQ = 4096
DEPTH = 1

GRID_W = 64
PLE_DIM = 256
D_ATTN = D_MODEL // 2
D_CONV = D_MODEL - D_ATTN
N_HEADS = 8
HEAD_DIM = D_ATTN // N_HEADS
N_CONV_GROUPS = 8
CONV_W = 3
WIN_ROWS_MAX = 8
WIN_COLS = 16
D_FF = 5632
RMS_EPS = 1e-6
D_IN = 3 * D_ATTN + 3 * D_CONV

kernel_name = 'hybrid_natten_shortconv_macaron_block'


def _rmsnorm(x, g):
    x32 = x.astype(jnp.float32)
    y = x32 * lax.rsqrt(jnp.mean(x32 * x32, axis=-1, keepdims=True) + RMS_EPS)
    return (y * g.astype(jnp.float32)).astype(x.dtype)


def _group_rmsnorm(x, g, n_groups):
    b, s, c = x.shape
    xg = x.reshape(b, s, n_groups, c // n_groups).astype(jnp.float32)
    y = xg * lax.rsqrt(jnp.mean(xg * xg, axis=-1, keepdims=True) + RMS_EPS)
    return (y.reshape(b, s, c) * g.astype(jnp.float32)).astype(x.dtype)


def _swiglu(x, wg, wu, wd):
    return (jax.nn.silu(x @ wg) * (x @ wu)) @ wd


def _neighbourhood_attention(q, k, v, rpb):
    b, s, h, dh = q.shape
    rows = s // GRID_W
    kr = min(WIN_ROWS_MAX, rows)
    r = jnp.arange(rows)
    row_start = jnp.clip(r - kr // 2, 0, rows - kr)
    row_idx = row_start[:, None] + jnp.arange(kr)[None, :]
    c = jnp.arange(GRID_W)
    col_start = jnp.clip(c - WIN_COLS // 2, 0, GRID_W - WIN_COLS)
    in_win = (c[None, :] >= col_start[:, None]) & (c[None, :] < col_start[:, None] + WIN_COLS)

    qg = q.reshape(b, rows, GRID_W, h, dh)
    kg = k.reshape(b, rows, GRID_W, h, dh)[:, row_idx]
    vg = v.reshape(b, rows, GRID_W, h, dh)[:, row_idx]

    scores = jnp.einsum('brqhd,brkwhd->bhrqkw', qg, kg).astype(jnp.float32) * (dh ** -0.5)

    rel_r = row_idx - r[:, None]
    rel_c = jnp.clip(c[None, :] - c[:, None], -(WIN_COLS - 1), WIN_COLS - 1)
    bias = rpb[:, rel_r[:, None, :, None] + (WIN_ROWS_MAX - 1),
               rel_c[None, :, None, :] + (WIN_COLS - 1)]
    scores = scores + bias.astype(jnp.float32)[None]
    scores = jnp.where(in_win[:, None, :], scores, -1e30)
    probs = jax.nn.softmax(scores, axis=(-2, -1))
    out = jnp.einsum('bhrqkw,brkwhd->brqhd', probs.astype(v.dtype), vg)
    return out.reshape(b, s, h * dh)


def _short_conv(u, w, bias):
    s = u.shape[1]
    pad = CONV_W // 2
    up = jnp.pad(u, ((0, 0), (pad, CONV_W - 1 - pad), (0, 0)))
    y = up[:, 0:s] * w[0]
    for j in range(1, CONV_W):
        y = y + up[:, j:j + s] * w[j]
    return y + bias


def setup_inputs(seed: int = 0) -> dict:
    key = jax.random.key(seed)
    ks = jax.random.split(key, 24)
    f32 = jnp.float32

    def nrm(k, shape, scale):
        return jax.random.normal(k, shape, f32) * scale

    def gain(k, shape):
        return 1.0 + 0.02 * jax.random.normal(k, shape, f32)

    L, D = DEPTH, D_MODEL
    return {
        'x': nrm(ks[0], (BATCH, SEQ, D), 1.0),
        'p': nrm(ks[1], (DEPTH, BATCH, SEQ, PLE_DIM), 1.0),
        'ffn1_norm': gain(ks[2], (L, D)),
        'ffn1_wg': nrm(ks[3], (L, D, D_FF), D ** -0.5),
        'ffn1_wu': nrm(ks[4], (L, D, D_FF), D ** -0.5),
        'ffn1_wd': nrm(ks[5], (L, D_FF, D), D_FF ** -0.5),
        'mix_norm': gain(ks[6], (L, D)),
        'w_in': nrm(ks[7], (L, D, D_IN), D ** -0.5),
        'rpb': nrm(ks[8], (L, N_HEADS, 2 * WIN_ROWS_MAX - 1, 2 * WIN_COLS - 1), 0.1),
        'conv_w': nrm(ks[9], (L, CONV_W, D_CONV), CONV_W ** -0.5),
        'conv_b': nrm(ks[10], (L, D_CONV), 0.01),
        'attn_out_norm': gain(ks[11], (L, D_ATTN)),
        'conv_out_norm': gain(ks[12], (L, D_CONV)),
        'w_out': nrm(ks[13], (L, D_ATTN + D_CONV, D), (D_ATTN + D_CONV) ** -0.5),
        'ffn2_norm': gain(ks[14], (L, D)),
        'ffn2_wg': nrm(ks[15], (L, D, D_FF), D ** -0.5),
        'ffn2_wu': nrm(ks[16], (L, D, D_FF), D ** -0.5),
        'ffn2_wd': nrm(ks[17], (L, D_FF, D), D_FF ** -0.5),
        'ple_norm': gain(ks[18], (L, D)),
        'ple_w_gate': nrm(ks[19], (L, D, D), D ** -0.5),
        'ple_w_proj': nrm(ks[20], (L, PLE_DIM, D), PLE_DIM ** -0.5),
        'final_norm': gain(ks[21], (D,)),
    }


def reference(x, p, ffn1_norm, ffn1_wg, ffn1_wu, ffn1_wd, mix_norm, w_in, rpb, conv_w, conv_b,
              attn_out_norm, conv_out_norm, w_out, ffn2_norm, ffn2_wg, ffn2_wu, ffn2_wd,
              ple_norm, ple_w_gate, ple_w_proj, final_norm):
    b, s, _ = x.shape
    splits = [D_ATTN, 2 * D_ATTN, 3 * D_ATTN, 3 * D_ATTN + D_CONV, 3 * D_ATTN + 2 * D_CONV]
    h = x
    for i in range(DEPTH):
        h = h + 0.5 * _swiglu(_rmsnorm(h, ffn1_norm[i]), ffn1_wg[i], ffn1_wu[i], ffn1_wd[i])

        a = _rmsnorm(h, mix_norm[i])
        z = a @ w_in[i]
        q, k, v, gate_b, gate_c, u = jnp.split(z, splits, axis=-1)
        q = q.reshape(b, s, N_HEADS, HEAD_DIM)
        k = k.reshape(b, s, N_HEADS, HEAD_DIM)
        v = v.reshape(b, s, N_HEADS, HEAD_DIM)
        y_attn = _neighbourhood_attention(q, k, v, rpb[i])
        y_conv = gate_b * _short_conv(gate_c * u, conv_w[i], conv_b[i])
        mixed = jnp.concatenate([
            _group_rmsnorm(y_attn, attn_out_norm[i], N_HEADS),
            _group_rmsnorm(y_conv, conv_out_norm[i], N_CONV_GROUPS)], axis=-1)
        h = h + mixed @ w_out[i]

        h = h + 0.5 * _swiglu(_rmsnorm(h, ffn2_norm[i]), ffn2_wg[i], ffn2_wu[i], ffn2_wd[i])

        g = jax.nn.sigmoid(_rmsnorm(h, ple_norm[i]) @ ple_w_gate[i])
        h = h + g * (p[i] @ ple_w_proj[i])
    return _rmsnorm(h, final_norm)
```

```cpp
#include <hip/hip_runtime.h>
#include <hip/hip_cooperative_groups.h>
#include <cstdio>
#include <cstdint>
namespace cg = cooperative_groups;
namespace pg8 {
#define PG8_LAS __attribute__((address_space(3)))
typedef unsigned short bf16_t;
typedef short bf16x8 __attribute__((ext_vector_type(8)));
typedef float f32x4 __attribute__((ext_vector_type(4)));
typedef unsigned u32x4 __attribute__((ext_vector_type(4)));
constexpr int BM = 256, BK = 64, HALF = 128, HTB = HALF * BK * 2  , STAGE_BYTES = 8 * HTB, NXCD = 8, WGM = 8;

__host__ __device__ __forceinline__ int lds_byte(int r, int c) { const int st = (r >> 4) * 2 + (c >> 5), rr = r & 15, cc = c & 31, ob = rr * 64 + cc * 2; return st * 1024 + (ob ^ (((ob >> 9) & 1) << 5)); }
__host__ __device__ __forceinline__ void stage_rc(int b, int& R, int& C) { const int st = b / 1024, sb = b % 1024, swz = sb ^ (((sb >> 9) & 1) << 5); R = (st >> 1) * 16 + swz / 64; C = (st & 1) * 32 + (swz % 64) / 2; }
__host__ __device__ __forceinline__ int perm32(int rho) { const int n = rho >> 4, i = rho & 15; return 8 * (i >> 2) + 4 * n + (i & 3); }

struct Unit { int pm, pn; };
struct Gemm { const bf16_t* A; const bf16_t* Bt; int M, N, K; };

struct StaticOrder {
    int nM, nN, nwg, G, c, wgm;
    __host__ __device__ void init(int M, int N, int G_, int c_, int wgm_ = WGM) { nM = M / BM; nN = N / BM; nwg = nM * nN; G = G_; c = c_; wgm = wgm_; }
    __host__ __device__ bool next(int i, Unit& u) const {
        const long L = (long)i * G + c; if (L >= nwg) return false;
        int wgid = (int)L; { const int q = nwg / NXCD, r = nwg % NXCD, xcd = wgid % NXCD, off = wgid / NXCD; wgid = (xcd < r ? xcd * (q + 1) : r * (q + 1) + (xcd - r) * q) + off; }
        const int nig = wgm * nN, gid = wgid / nig, fm = gid * wgm, gsz = (nM - fm) < wgm ? (nM - fm) : wgm;
        u.pm = fm + ((wgid % nig) % gsz); u.pn = (wgid % nig) / gsz; return true;
    }
    __device__ __forceinline__ void a_ready(const Unit&) const {}
    __device__ __forceinline__ void done(const Unit&) const {}
};

__device__ __forceinline__ unsigned cvt_pk_bf16(float lo, float hi) { unsigned r; asm volatile("v_cvt_pk_bf16_f32 %0, %1, %2" : "=v"(r) : "v"(lo), "v"(hi)); return r; }
__device__ __forceinline__ int lane_id_v() { int l; asm volatile("v_mbcnt_lo_u32_b32 %0, -1, 0\n\tv_mbcnt_hi_u32_b32 %0, -1, %0" : "=v"(l)); return l; }
typedef int i32x4v __attribute__((ext_vector_type(4)));
typedef int i32x8v __attribute__((ext_vector_type(8)));
template <class Epi, class Sched, bool ALIGN_EPI = false, bool SP2 = false, bool FP8 = false>
__device__ __forceinline__ void gemm_phase(PG8_LAS unsigned char* lds, const Gemm g, const Sched& S, const Epi& E, const int wid  ) {
    const int lane = lane_id_v(), tid = wid * 64 + lane, wr = wid >> 2, wc = wid & 3, fr = lane & 15, fq = lane >> 4;
    int sc1 = 0x7F7F7F7F; asm volatile("" : "+v"(sc1));
    const int K = g.K, nt = K / BK;
    unsigned voffA[2], voffB[2];
#pragma unroll
    for (int i = 0; i < 2; ++i) { int R, C; stage_rc(tid * 16 + i * 8192, R, C); const int Rb = Epi::PERM ? ((R & ~31) + perm32(R & 31)) : R;
        voffA[i] = (unsigned)(R * K + C) * 2u; voffB[i] = (unsigned)(Rb * K + C) * 2u; }
    const size_t kstep = (size_t)(BK * 2);
    size_t hstep = (size_t)HALF * K * 2;
    const size_t tstep = 2 * hstep;
    const unsigned ldsw = (unsigned)wid * 1024u;
    const int aoff = lds_byte(wr * 64 + fr, fq * 8), boff = lds_byte(wc * 32 + fr, fq * 8);
#define PG8_SA(b, h) (((b) * 2 + (h)) * HTB)
#define PG8_SB(b, h) ((4 + (b) * 2 + (h)) * HTB)
#define PG8_STAGE(bufoff, gbase, voff) do { _Pragma("unroll") for (int _i = 0; _i < 2; ++_i) \
        __builtin_amdgcn_global_load_lds((const unsigned*)((const char*)(gbase) + (voff)[_i]), (PG8_LAS unsigned*)(lds + (bufoff) + ldsw + _i * 8192), 16, 0, 0); } while (0)
#define PG8_LDA(dst, b, h) do { if constexpr (FP8) { _Pragma("unroll") for (int m = 0; m < 4; ++m) { const i32x4v lo_ = *(const PG8_LAS i32x4v*)(lds + PG8_SA(b, h) + aoff + m * 2048), hi_ = *(const PG8_LAS i32x4v*)(lds + PG8_SA(b, h) + aoff + m * 2048 + 1024); dst##8[m] = __builtin_shufflevector(lo_, hi_, 0, 1, 2, 3, 4, 5, 6, 7); } } else { \
        _Pragma("unroll") for (int m = 0; m < 4; ++m) _Pragma("unroll") for (int k = 0; k < 2; ++k) dst[m][k] = *(const PG8_LAS bf16x8*)(lds + PG8_SA(b, h) + aoff + m * 2048 + k * 1024); } } while (0)
#define PG8_LDB(dst, b, h) do { if constexpr (FP8) { _Pragma("unroll") for (int n = 0; n < 2; ++n) { const i32x4v lo_ = *(const PG8_LAS i32x4v*)(lds + PG8_SB(b, h) + boff + n * 2048), hi_ = *(const PG8_LAS i32x4v*)(lds + PG8_SB(b, h) + boff + n * 2048 + 1024); dst##8[n] = __builtin_shufflevector(lo_, hi_, 0, 1, 2, 3, 4, 5, 6, 7); } } else { \
        _Pragma("unroll") for (int n = 0; n < 2; ++n) _Pragma("unroll") for (int k = 0; k < 2; ++k) dst[n][k] = *(const PG8_LAS bf16x8*)(lds + PG8_SB(b, h) + boff + n * 2048 + k * 1024); } } while (0)
#define PG8_MMA(ai, bj, Af, Bf) do { __builtin_amdgcn_s_setprio(1); if constexpr (FP8) { _Pragma("unroll") for (int m = 0; m < 4; ++m) _Pragma("unroll") for (int n = 0; n < 2; ++n) \
        asm volatile("v_mfma_scale_f32_16x16x128_f8f6f4 %0, %1, %2, %0, %3, %3 op_sel_hi:[0,0,0]" : "+v"(acc[ai][bj][m][n]) : "v"(Bf##8[n]), "v"(Af##8[m]), "v"(sc1)); } else { \
        _Pragma("unroll") for (int m = 0; m < 4; ++m) _Pragma("unroll") for (int n = 0; n < 2; ++n) _Pragma("unroll") for (int k = 0; k < 2; ++k) \
        acc[ai][bj][m][n] = __builtin_amdgcn_mfma_f32_16x16x32_bf16(Bf[n][k], Af[m][k], acc[ai][bj][m][n], 0, 0, 0); } __builtin_amdgcn_s_setprio(0); } while (0)
#define PG8_WAIT_V(n) asm volatile("s_waitcnt vmcnt(" #n ")" ::: "memory")
#define PG8_WAIT_L(n) asm volatile("s_waitcnt lgkmcnt(" #n ")" ::: "memory")
#define PG8_BAR __builtin_amdgcn_s_barrier()
#define PG8_SCHED __builtin_amdgcn_sched_barrier(0)
    Unit cur, nxt; int ui = 0;
    if (!S.next(0, cur)) return;
    f32x4 acc[2][2][4][2];
#pragma unroll
    for (int a = 0; a < 2; ++a)
#pragma unroll
        for (int b = 0; b < 2; ++b)
#pragma unroll
            for (int m = 0; m < 4; ++m)
#pragma unroll
                for (int n = 0; n < 2; ++n) acc[a][b][m][n] = (f32x4){0.f, 0.f, 0.f, 0.f};
    bf16x8 At[4][2], B0[2][2], B1[2][2]; i32x8v At8[4], B08[2], B18[2];
    const char* cA = (const char*)g.A + (size_t)cur.pm * tstep; const char* cB = (const char*)g.Bt + (size_t)cur.pn * tstep;
    S.a_ready(cur);
    if constexpr (SP2) {
        PG8_STAGE(PG8_SB(0, 0), cB, voffB); PG8_STAGE(PG8_SB(0, 1), cB + hstep, voffB); PG8_STAGE(PG8_SA(0, 0), cA, voffA); PG8_STAGE(PG8_SA(0, 1), cA + hstep, voffA);
        if (wr == 1) PG8_BAR;
        PG8_WAIT_V(2); PG8_BAR;
        PG8_STAGE(PG8_SB(1, 0), cB + kstep, voffB); PG8_STAGE(PG8_SA(1, 0), cA + kstep, voffA); PG8_STAGE(PG8_SB(1, 1), cB + hstep + kstep, voffB);
        PG8_WAIT_V(6); PG8_BAR;
    } else {
        PG8_STAGE(PG8_SB(0, 0), cB, voffB); PG8_STAGE(PG8_SA(0, 0), cA, voffA); PG8_STAGE(PG8_SB(0, 1), cB + hstep, voffB); PG8_STAGE(PG8_SA(0, 1), cA + hstep, voffA);
        if (wr == 1) PG8_BAR;
        PG8_WAIT_V(4); PG8_BAR;
        PG8_STAGE(PG8_SB(1, 0), cB + kstep, voffB); PG8_STAGE(PG8_SA(1, 0), cA + kstep, voffA); PG8_STAGE(PG8_SB(1, 1), cB + hstep + kstep, voffB);
        PG8_WAIT_V(6); PG8_BAR;
    }
    for (;;) {
        const bool has_next = S.next(ui + 1, nxt);
        const char* nA = has_next ? (const char*)g.A + (size_t)nxt.pm * tstep : cA; const char* nB = has_next ? (const char*)g.Bt + (size_t)nxt.pn * tstep : cB;
        if constexpr (Epi::RESID_DMA) { if (!has_next) { nA = E.resid_tile(cur); nB = nA + 256; } }
        for (int t = 0; t < nt; t += 2) {
            const bool last = (t == nt - 2);
            const char* a1 = cA + (size_t)(t + 1) * kstep;
            const char* a2 = last ? nA : cA + (size_t)(t + 2) * kstep; const char* b2 = last ? nB : cB + (size_t)(t + 2) * kstep;
            const char* a3 = a2 + kstep; const char* b3 = b2 + kstep;
            if (last && has_next) S.a_ready(nxt);
            if constexpr (SP2) {
            PG8_LDB(B0, 0, 0); PG8_LDB(B1, 0, 1); PG8_SCHED; PG8_LDA(At, 0, 0); PG8_STAGE(PG8_SA(1, 1), a1 + hstep, voffA);
            PG8_WAIT_V(8); PG8_WAIT_L(0); PG8_BAR; PG8_MMA(0, 0, At, B0); PG8_MMA(0, 1, At, B1); PG8_BAR; PG8_SCHED;
            if constexpr (Epi::RESID_DMA) { if (last && !has_next) {
                _Pragma("unroll") for (int i = 0; i < 2; ++i) { int R, C; stage_rc(tid * 16 + i * 8192, R, C); voffA[i] = voffB[i] = (unsigned)(R * 2048 + C) * 2u; }
                hstep = (size_t)HALF * 2048 * 2; } }
            PG8_LDA(At, 0, 1); PG8_STAGE(PG8_SB(0, 0), b2, voffB); PG8_STAGE(PG8_SB(0, 1), b2 + hstep, voffB); PG8_STAGE(PG8_SA(0, 0), a2, voffA);
            PG8_WAIT_V(8); PG8_WAIT_L(0); PG8_BAR; PG8_MMA(1, 0, At, B0); PG8_MMA(1, 1, At, B1); PG8_BAR; PG8_SCHED;
            PG8_LDB(B0, 1, 0); PG8_LDB(B1, 1, 1); PG8_SCHED; PG8_LDA(At, 1, 0); PG8_STAGE(PG8_SA(0, 1), a2 + hstep, voffA);
            PG8_WAIT_V(8); PG8_WAIT_L(0); PG8_BAR; PG8_MMA(0, 0, At, B0); PG8_MMA(0, 1, At, B1); PG8_BAR; PG8_SCHED;
            PG8_LDA(At, 1, 1); PG8_STAGE(PG8_SB(1, 0), b3, voffB); PG8_STAGE(PG8_SB(1, 1), b3 + hstep, voffB); PG8_STAGE(PG8_SA(1, 0), a3, voffA);
            PG8_WAIT_V(8); PG8_WAIT_L(0); PG8_BAR; PG8_MMA(1, 0, At, B0); PG8_MMA(1, 1, At, B1); PG8_BAR; PG8_SCHED;
            } else {
            PG8_LDB(B0, 0, 0); PG8_SCHED; PG8_LDA(At, 0, 0); PG8_STAGE(PG8_SA(1, 1), a1 + hstep, voffA);
            PG8_WAIT_L(8); PG8_BAR; PG8_WAIT_L(0); PG8_MMA(0, 0, At, B0); PG8_BAR; PG8_SCHED;
            PG8_LDB(B1, 0, 1); PG8_STAGE(PG8_SB(0, 0), b2, voffB);
            PG8_BAR; PG8_WAIT_L(0); PG8_MMA(0, 1, At, B1); PG8_BAR;
            PG8_LDA(At, 0, 1); PG8_STAGE(PG8_SA(0, 0), a2, voffA);
            PG8_BAR; PG8_WAIT_L(0); PG8_MMA(1, 0, At, B0); PG8_BAR; PG8_SCHED;
            PG8_STAGE(PG8_SB(0, 1), b2 + hstep, voffB);
            PG8_WAIT_V(6); PG8_BAR; PG8_MMA(1, 1, At, B1); PG8_BAR;
            PG8_LDB(B0, 1, 0); PG8_SCHED; PG8_LDA(At, 1, 0); PG8_STAGE(PG8_SA(0, 1), a2 + hstep, voffA);
            PG8_WAIT_L(8); PG8_BAR; PG8_WAIT_L(0); PG8_MMA(0, 0, At, B0); PG8_BAR; PG8_SCHED;
            PG8_LDB(B1, 1, 1); PG8_STAGE(PG8_SB(1, 0), b3, voffB);
            PG8_BAR; PG8_WAIT_L(0); PG8_MMA(0, 1, At, B1); PG8_BAR;
            PG8_LDA(At, 1, 1); PG8_STAGE(PG8_SA(1, 0), a3, voffA);
            PG8_BAR; PG8_WAIT_L(0); PG8_MMA(1, 0, At, B0); PG8_BAR; PG8_SCHED;
            PG8_STAGE(PG8_SB(1, 1), b3 + hstep, voffB);
            PG8_WAIT_V(6); PG8_BAR; PG8_MMA(1, 1, At, B1); PG8_BAR;
            }
        }
        if constexpr (ALIGN_EPI) { if (wr == 0) PG8_BAR; }
        if constexpr (FP8) asm volatile("s_nop 15\n\ts_nop 15\n\ts_nop 15" ::: "memory");
        if constexpr (!Epi::AFTER_DRAIN) { E(acc, cur, wr, wc, fr, fq); S.done(cur); }
        if (!has_next) break;
#pragma unroll
        for (int a = 0; a < 2; ++a)
#pragma unroll
            for (int b = 0; b < 2; ++b)
#pragma unroll
                for (int m = 0; m < 4; ++m)
#pragma unroll
                    for (int n = 0; n < 2; ++n) acc[a][b][m][n] = (f32x4){0.f, 0.f, 0.f, 0.f};
        cur = nxt; cA = nA; cB = nB; ++ui;
        if constexpr (ALIGN_EPI) { if (wr == 1) PG8_BAR; }
    }
    PG8_WAIT_V(0);
    if constexpr (!ALIGN_EPI) { if (wr == 0) PG8_BAR; }
    PG8_BAR;
    if constexpr (Epi::AFTER_DRAIN) { if constexpr (FP8) asm volatile("s_nop 15\n\ts_nop 15\n\ts_nop 15" ::: "memory"); E.fused(acc, cur, wr, wc, fr, fq, lds, wid, lane); S.done(cur); }
#undef PG8_SA
#undef PG8_SB
#undef PG8_STAGE
#undef PG8_LDA
#undef PG8_LDB
#undef PG8_MMA
#undef PG8_WAIT_V
#undef PG8_WAIT_L
#undef PG8_BAR
#undef PG8_SCHED
}
}

#define LAS __attribute__((address_space(3)))
using pg8::bf16_t; using pg8::bf16x8; using pg8::f32x4; using pg8::u32x4; using pg8::cvt_pk_bf16;
typedef unsigned v4u __attribute__((ext_vector_type(4)));
typedef unsigned v2u __attribute__((ext_vector_type(2)));
constexpr int MTOK = 8192, DM = 2048, FF = 5632, SEQ = 4096, PLE = 256, NGRP = 3072;
constexpr float EPS = 1e-6f;
constexpr float ACT_SCALE = 8.f, WD_SCALE = 1024.f, H_SCALE = 16.f;
constexpr size_t MiB = 1u << 20;
constexpr size_t WS_SSQ = 0, WS_WGU1 = 1 * MiB, WS_WD1 = 45 * MiB, WS_WIN = 67 * MiB, WS_WINV = 87 * MiB, WS_WOUT = 91 * MiB, WS_WGU2 = 99 * MiB, WS_WD2 = 143 * MiB,
                 WS_WGATE = 165 * MiB, WS_WPLE = 173 * MiB, WS_HB = 174 * MiB, WS_PB = 206 * MiB, WS_ACT = 210 * MiB, WS_QK = 210 * MiB, WS_VT = 242 * MiB, WS_MIX = 258 * MiB,
                 WS_G = 298 * MiB, WS_PROJ = 298 * MiB, WS_HB8 = 330 * MiB  , WS_END = 346 * MiB;
constexpr size_t QK_STRIDE = (size_t)MTOK * 1024;
constexpr int LDS_BYTES = 147456, LDS_MISC = 147392;
constexpr size_t WS_BAR = 512 * 1024;


__device__ __forceinline__ float bf_lo(unsigned w) { return __uint_as_float(w << 16); }
__device__ __forceinline__ float bf_hi(unsigned w) { return __uint_as_float(w & 0xffff0000u); }
__device__ __forceinline__ float rs_of(float ssq) { return rsqrtf(ssq * (1.f / 2048.f) + EPS); }
__device__ __forceinline__ float f8_clamp(float x) { return __builtin_amdgcn_fmed3f(x, -448.0f, 448.0f); }
__device__ __forceinline__ float sigmoid_f(float x) { return __builtin_amdgcn_rcpf(1.f + __builtin_amdgcn_exp2f(-1.4426950408889634f * x)); }
__device__ __forceinline__ float wave_sum(float v) {
#pragma unroll
    for (int o = 1; o < 64; o <<= 1) v += __shfl_xor(v, o);
    return v;
}

#define XB_LAS LAS
#define XB_TMO      128
#define XB_XCNT(j)  (256  + 64 * (j))
#define XB_XSUB(j)  (1280 + 64 * (j))
#define XB_XGEN(j)  (2304 + 64 * (j))
#define XB_TOP      3328
#define XB_TOPGEN   3392
#define XCD_BAR_WORDS 3456
#define XB_SPIN_CAP (1u << 18)

__device__ __forceinline__ unsigned xb_ld(unsigned* p)              { return __hip_atomic_load(p, __ATOMIC_RELAXED, __HIP_MEMORY_SCOPE_AGENT); }
__device__ __forceinline__ unsigned xb_add(unsigned* p, unsigned v) { return __hip_atomic_fetch_add(p, v, __ATOMIC_RELAXED, __HIP_MEMORY_SCOPE_AGENT); }
__device__ __forceinline__ unsigned xb_xcc_id() { return (unsigned)__builtin_amdgcn_s_getreg((3 << 11) | 20) & 0xFu; }
#define XB_SPIN(cond, bar) do { unsigned _sp = 0; while (cond) { __builtin_amdgcn_s_sleep(1); \
    if ((++_sp & 255u) == 0u) { if (xb_ld(&(bar)[XB_TMO])) break; if (_sp > XB_SPIN_CAP) { atomicAdd(&(bar)[XB_TMO], 1u); break; } } } } while (0)

struct XcdBarrier {
    unsigned* bar; unsigned x;
    volatile LAS unsigned* st;
};

__device__ __forceinline__ XcdBarrier xcd_barrier_post(unsigned* bar, volatile LAS unsigned* st, const bool leader_) {
    XcdBarrier b; b.bar = bar; b.x = xb_xcc_id(); b.st = st;
    if (leader_) (void)xb_add(&bar[XB_XCNT(b.x)], 1u);
    return b;
}
__device__ __forceinline__ void xcd_barrier_complete(unsigned* bar, unsigned x, unsigned& nloc, unsigned& nx) {
    const unsigned G = gridDim.x * gridDim.y * gridDim.z;
    unsigned sum, cnt, mine, sp = 0u;
    for (;;) {
        sum = 0u; cnt = 0u; mine = 0u;
#pragma unroll
        for (unsigned j = 0; j < 16; ++j) { const unsigned c = xb_ld(&bar[XB_XCNT(j)]); sum += c; cnt += (c > 0u) ? 1u : 0u; mine = (j == x) ? c : mine; }
        if (sum == G) break;
        __builtin_amdgcn_s_sleep(1);
        if ((++sp & 255u) == 0u) { if (xb_ld(&bar[XB_TMO])) break; if (sp > XB_SPIN_CAP) { atomicAdd(&bar[XB_TMO], 1u); break; } }
    }
    nloc = mine > 0u ? mine : 1u; nx = cnt > 0u ? cnt : 1u;
}

__device__ __forceinline__ void xcd_barrier(const XcdBarrier& b, const bool leader_) {
    asm volatile("s_waitcnt vmcnt(0)" ::: "memory");
    __syncthreads();
    if (leader_) {
        unsigned* bar = b.bar;
        __builtin_amdgcn_s_waitcnt(0);
        unsigned nloc = b.st[0], nx = b.st[1];
        if (nloc == 0u) { xcd_barrier_complete(bar, b.x, nloc, nx); b.st[0] = nloc; b.st[1] = nx; }
        const unsigned old = xb_add(&bar[XB_XSUB(b.x)], 1u);
        const unsigned gen = old / nloc;
        if (old + 1u == (gen + 1u) * nloc) {
            __builtin_amdgcn_fence(__ATOMIC_RELEASE, "agent");
            asm volatile("s_waitcnt vmcnt(0)" ::: "memory");
            const unsigned og = xb_add(&bar[XB_TOP], 1u);
            const unsigned tg = og / nx;
            if (og + 1u == (tg + 1u) * nx) xb_add(&bar[XB_TOPGEN], 1u);
            else XB_SPIN(xb_ld(&bar[XB_TOPGEN]) == tg, bar);
            __builtin_amdgcn_fence(__ATOMIC_ACQUIRE, "agent");
            xb_add(&bar[XB_XGEN(b.x)], 1u);
            asm volatile("s_waitcnt vmcnt(0)" ::: "memory");
        } else {
            XB_SPIN(xb_ld(&bar[XB_XGEN(b.x)]) == gen, bar);
            __builtin_amdgcn_fence(__ATOMIC_ACQUIRE, "agent");
            asm volatile("s_waitcnt vmcnt(0)" ::: "memory");
        }
    }
    __syncthreads();
}

template <bool F8> struct EpiSwiGLU {
    static constexpr bool PERM = true, AFTER_DRAIN = false, RESID_DMA = false;
    unsigned char* O; const float* ssq; float mul;
    __device__ __forceinline__ void operator()(const f32x4 (&acc)[2][2][4][2], const pg8::Unit& u, int wr, int wc, int fr, int fq) const {
        const int row0 = u.pm * 256 + wr * 64 + fr, col0 = u.pn * 128 + wc * 32 + 8 * fq;
        float sq[2][4];
#pragma unroll
        for (int ai = 0; ai < 2; ++ai)
#pragma unroll
            for (int m = 0; m < 4; ++m) sq[ai][m] = ssq[row0 + ai * 128 + m * 16];
#pragma unroll
        for (int ai = 0; ai < 2; ++ai)
#pragma unroll
            for (int m = 0; m < 4; ++m) {
                const int row = row0 + ai * 128 + m * 16; const float r = rs_of(sq[ai][m]) * mul, rn = r * -1.4426950408889634f, ru = r * (F8 ? ACT_SCALE : 1.f);
                float o[8];
#pragma unroll
                for (int n = 0; n < 2; ++n) {
                    const f32x4 ag = acc[ai][0][m][n], Gv = ag * r, Tv = ag * rn, Uv = acc[ai][1][m][n] * ru;
                    f32x4 Ev; Ev[0] = __builtin_amdgcn_exp2f(Tv[0]); Ev[1] = __builtin_amdgcn_exp2f(Tv[1]); Ev[2] = __builtin_amdgcn_exp2f(Tv[2]); Ev[3] = __builtin_amdgcn_exp2f(Tv[3]);
                    Ev = Ev + 1.0f;
                    f32x4 Sv; Sv[0] = __builtin_amdgcn_rcpf(Ev[0]); Sv[1] = __builtin_amdgcn_rcpf(Ev[1]); Sv[2] = __builtin_amdgcn_rcpf(Ev[2]); Sv[3] = __builtin_amdgcn_rcpf(Ev[3]);
                    const f32x4 Ov = (Gv * Sv) * Uv;
                    o[4 * n + 0] = Ov[0]; o[4 * n + 1] = Ov[1]; o[4 * n + 2] = Ov[2]; o[4 * n + 3] = Ov[3];
                }
                if constexpr (F8) {
                int w0 = __builtin_amdgcn_cvt_pk_fp8_f32(f8_clamp(o[0]), f8_clamp(o[1]), 0, false); w0 = __builtin_amdgcn_cvt_pk_fp8_f32(f8_clamp(o[2]), f8_clamp(o[3]), w0, true);
                int w1 = __builtin_amdgcn_cvt_pk_fp8_f32(f8_clamp(o[4]), f8_clamp(o[5]), 0, false); w1 = __builtin_amdgcn_cvt_pk_fp8_f32(f8_clamp(o[6]), f8_clamp(o[7]), w1, true);
                v2u w; w.x = (unsigned)w0; w.y = (unsigned)w1;
                *(v2u*)(O + (size_t)row * FF + col0) = w;
                } else {
                u32x4 w; w.x = cvt_pk_bf16(o[0], o[1]); w.y = cvt_pk_bf16(o[2], o[3]); w.z = cvt_pk_bf16(o[4], o[5]); w.w = cvt_pk_bf16(o[6], o[7]);
                *(u32x4*)((bf16_t*)O + (size_t)row * FF + col0) = w; }
            }
    }
};
template <bool RES16, bool OUT8> struct EpiResid {
    static constexpr bool PERM = true, AFTER_DRAIN = false, RESID_DMA = false;
    const float* R; bf16_t* HB; unsigned char* HB8; float* ssq; float alpha;
    __device__ __forceinline__ void operator()(const f32x4 (&acc)[2][2][4][2], const pg8::Unit& u, int wr, int wc, int fr, int fq) const {
        const int row0 = u.pm * 256 + wr * 64 + fr, col0 = u.pn * 256 + wc * 32 + 8 * fq;
#pragma unroll
        for (int ai = 0; ai < 2; ++ai)
#pragma unroll
            for (int m = 0; m < 4; ++m) {
                const int row = row0 + ai * 128 + m * 16; float s = 0.f;
#pragma unroll
                for (int bj = 0; bj < 2; ++bj) {
                    const size_t off = (size_t)row * DM + col0 + bj * 128;
                    f32x4 r0, r1;
                    if constexpr (RES16) { const v4u q = *(const v4u*)(HB + off); r0 = (f32x4){bf_lo(q.x), bf_hi(q.x), bf_lo(q.y), bf_hi(q.y)}; r1 = (f32x4){bf_lo(q.z), bf_hi(q.z), bf_lo(q.w), bf_hi(q.w)}; }
                    else { r0 = __builtin_nontemporal_load((const f32x4*)(R + off)); r1 = __builtin_nontemporal_load((const f32x4*)(R + off + 4)); }
                    const f32x4 v0 = r0 + acc[ai][bj][m][0] * alpha, v1 = r1 + acc[ai][bj][m][1] * alpha;
                    if constexpr (OUT8) {
                        int w0 = __builtin_amdgcn_cvt_pk_fp8_f32(f8_clamp(v0[0] * H_SCALE), f8_clamp(v0[1] * H_SCALE), 0, false); w0 = __builtin_amdgcn_cvt_pk_fp8_f32(f8_clamp(v0[2] * H_SCALE), f8_clamp(v0[3] * H_SCALE), w0, true);
                        int w1 = __builtin_amdgcn_cvt_pk_fp8_f32(f8_clamp(v1[0] * H_SCALE), f8_clamp(v1[1] * H_SCALE), 0, false); w1 = __builtin_amdgcn_cvt_pk_fp8_f32(f8_clamp(v1[2] * H_SCALE), f8_clamp(v1[3] * H_SCALE), w1, true);
                        v2u w; w.x = (unsigned)w0; w.y = (unsigned)w1; *(v2u*)(HB8 + off) = w;
                    }
                    { u32x4 w; w.x = cvt_pk_bf16(v0[0], v0[1]); w.y = cvt_pk_bf16(v0[2], v0[3]); w.z = cvt_pk_bf16(v1[0], v1[1]); w.w = cvt_pk_bf16(v1[2], v1[3]);
                      *(u32x4*)(HB + off) = w; }
                    s += (v0[0] * v0[0] + v0[1] * v0[1]) + (v0[2] * v0[2] + v0[3] * v0[3]) + (v1[0] * v1[0] + v1[1] * v1[1]) + (v1[2] * v1[2] + v1[3] * v1[3]);
                }
                s += __shfl_xor(s, 16); s += __shfl_xor(s, 32);
                if (fq == 0) unsafeAtomicAdd(ssq + row, s);
            }
    }
};
template <bool OUT8> struct EpiResidL {
    static constexpr bool PERM = true, AFTER_DRAIN = true, RESID_DMA = true;
    bf16_t* HB; unsigned char* HB8; float* ssq; float alpha;
    __device__ __forceinline__ const char* resid_tile(const pg8::Unit& u) const { return (const char*)(HB + (size_t)(u.pm * 256) * DM + u.pn * 256); }
    __device__ __forceinline__ void fused(f32x4 (&acc)[2][2][4][2], const pg8::Unit& u, int wr, int wc, int fr, int fq, LAS unsigned char* img, int wid, int lane) const {
        const int row0 = u.pm * 256 + wr * 64 + fr, col0 = u.pn * 256 + wc * 32 + 8 * fq;
        bf16_t* gtile = HB + (size_t)(u.pm * 256) * DM + u.pn * 256;
        v4u qm[4];
        if (wc >= 2) {
#pragma unroll
            for (int m = 0; m < 4; ++m) qm[m] = *(const v4u*)(HB + (size_t)(row0 + 128 + m * 16) * DM + col0);
        }
#pragma unroll
        for (int ai = 0; ai < 2; ++ai)
#pragma unroll
            for (int m = 0; m < 4; ++m) {
                const int row = row0 + ai * 128 + m * 16, rl = wr * 64 + m * 16 + fr; float s = 0.f;
#pragma unroll
                for (int bj = 0; bj < 2; ++bj) {
                    const size_t off = (size_t)row * DM + col0 + bj * 128;
                    LAS v4u* slot = (LAS v4u*)(img + ((bj * 2 + (wc >> 1)) * 2 + ai) * 16384 + pg8::lds_byte(rl, (wc & 1) * 32 + fq * 8));
                    v4u q = *slot;
                    if (ai == 1 && bj == 0) { if (wc >= 2) q = qm[m]; }
                    const f32x4 r0 = (f32x4){bf_lo(q.x), bf_hi(q.x), bf_lo(q.y), bf_hi(q.y)}, r1 = (f32x4){bf_lo(q.z), bf_hi(q.z), bf_lo(q.w), bf_hi(q.w)};
                    const f32x4 v0 = r0 + acc[ai][bj][m][0] * alpha, v1 = r1 + acc[ai][bj][m][1] * alpha;
                    if constexpr (OUT8) {
                        int w0 = __builtin_amdgcn_cvt_pk_fp8_f32(f8_clamp(v0[0] * H_SCALE), f8_clamp(v0[1] * H_SCALE), 0, false); w0 = __builtin_amdgcn_cvt_pk_fp8_f32(f8_clamp(v0[2] * H_SCALE), f8_clamp(v0[3] * H_SCALE), w0, true);
                        int w1 = __builtin_amdgcn_cvt_pk_fp8_f32(f8_clamp(v1[0] * H_SCALE), f8_clamp(v1[1] * H_SCALE), 0, false); w1 = __builtin_amdgcn_cvt_pk_fp8_f32(f8_clamp(v1[2] * H_SCALE), f8_clamp(v1[3] * H_SCALE), w1, true);
                        v2u w; w.x = (unsigned)w0; w.y = (unsigned)w1; *(v2u*)(HB8 + off) = w;
                    }
                    { v4u w; w.x = cvt_pk_bf16(v0[0], v0[1]); w.y = cvt_pk_bf16(v0[2], v0[3]); w.z = cvt_pk_bf16(v1[0], v1[1]); w.w = cvt_pk_bf16(v1[2], v1[3]); *slot = w; }
                    s += (v0[0] * v0[0] + v0[1] * v0[1]) + (v0[2] * v0[2] + v0[3] * v0[3]) + (v1[0] * v1[0] + v1[1] * v1[1]) + (v1[2] * v1[2] + v1[3] * v1[3]);
                }
                s += __shfl_xor(s, 16); s += __shfl_xor(s, 32);
                if (fq == 0) unsafeAtomicAdd(ssq + row, s);
            }
        asm volatile("s_waitcnt lgkmcnt(0)" ::: "memory"); __builtin_amdgcn_s_barrier(); asm volatile("" ::: "memory");
        const int rr = wid * 32 + (lane >> 5), cc = lane & 31;
#pragma unroll
        for (int j = 0; j < 16; ++j) { const int r = rr + 2 * j;
            const v4u w = *(const LAS v4u*)(img + ((cc >> 3) * 2 + (r >> 7)) * 16384 + pg8::lds_byte(r & 127, (cc & 7) * 8));
            *(v4u*)(gtile + (size_t)r * DM + cc * 8) = w; }
        asm volatile("s_waitcnt lgkmcnt(0)" ::: "memory"); __builtin_amdgcn_s_barrier(); asm volatile("" ::: "memory");
    }
};
struct EpiWin {
    static constexpr bool PERM = true, AFTER_DRAIN = false, RESID_DMA = false;
    bf16_t* QK; bf16_t* G; const float* ssq;
    __device__ __forceinline__ void operator()(const f32x4 (&acc)[2][2][4][2], const pg8::Unit& u, int wr, int wc, int fr, int fq) const {
        const int row0 = u.pm * 256 + wr * 64 + fr, cin = wc * 32 + 8 * fq;
        float sq[2][4];
#pragma unroll
        for (int ai = 0; ai < 2; ++ai)
#pragma unroll
            for (int m = 0; m < 4; ++m) sq[ai][m] = ssq[row0 + ai * 128 + m * 16];
#pragma unroll
        for (int ai = 0; ai < 2; ++ai)
#pragma unroll
            for (int m = 0; m < 4; ++m) {
                const int row = row0 + ai * 128 + m * 16; const float r = rs_of(sq[ai][m]);
#pragma unroll
                for (int bj = 0; bj < 2; ++bj) {
                    const f32x4 v0 = acc[ai][bj][m][0] * r, v1 = acc[ai][bj][m][1] * r;
                    u32x4 w; w.x = cvt_pk_bf16(v0[0], v0[1]); w.y = cvt_pk_bf16(v0[2], v0[3]); w.z = cvt_pk_bf16(v1[0], v1[1]); w.w = cvt_pk_bf16(v1[2], v1[3]);
                    bf16_t* dst;
                    if (u.pn < 8) { const int which = u.pn >> 2, head = (u.pn & 3) * 2 + bj, b = row >> 12, t = row & 4095;
                        dst = QK + (size_t)which * QK_STRIDE + ((size_t)((b * 8 + head) * 4096 + t)) * 128 + cin; }
                    else dst = G + (size_t)row * NGRP + (u.pn - 8) * 256 + bj * 128 + cin;
                    *(u32x4*)dst = w;
                }
            }
    }
};
struct EpiCol {
    static constexpr bool PERM = true, AFTER_DRAIN = false, RESID_DMA = false;
    bf16_t* O; int ldc; const float* ssq;
    __device__ __forceinline__ void operator()(const f32x4 (&acc)[2][2][4][2], const pg8::Unit& u, int wr, int wc, int fr, int fq) const {
        const int row0 = u.pm * 256 + wr * 64 + fr, col0 = u.pn * 256 + wc * 32 + 8 * fq;
        f32x4 cs[2][2];
#pragma unroll
        for (int bj = 0; bj < 2; ++bj)
#pragma unroll
            for (int n = 0; n < 2; ++n) {
                if (ssq) { const f32x4 q = *(const f32x4*)(ssq + col0 + bj * 128 + 4 * n); cs[bj][n] = (f32x4){rs_of(q[0]), rs_of(q[1]), rs_of(q[2]), rs_of(q[3])}; }
                else cs[bj][n] = (f32x4){1.f, 1.f, 1.f, 1.f};
            }
#pragma unroll
        for (int ai = 0; ai < 2; ++ai)
#pragma unroll
            for (int m = 0; m < 4; ++m) {
                const int row = row0 + ai * 128 + m * 16;
#pragma unroll
                for (int bj = 0; bj < 2; ++bj) {
                    const f32x4 v0 = acc[ai][bj][m][0] * cs[bj][0], v1 = acc[ai][bj][m][1] * cs[bj][1];
                    u32x4 w; w.x = cvt_pk_bf16(v0[0], v0[1]); w.y = cvt_pk_bf16(v0[2], v0[3]); w.z = cvt_pk_bf16(v1[0], v1[1]); w.w = cvt_pk_bf16(v1[2], v1[3]);
                    *(u32x4*)(O + (size_t)row * ldc + col0 + bj * 128) = w;
                }
            }
    }
};
struct EpiPleNorm {
    static constexpr bool PERM = true, AFTER_DRAIN = false, RESID_DMA = false;
    const bf16_t* H; float* OUT; const bf16_t* PROJ; const float* ssq3; float* ssq4; unsigned* cnt; const float* gfin; float mul;
    __device__ __forceinline__ void operator()(f32x4 (&acc)[2][2][4][2], const pg8::Unit& u, int wr, int wc, int fr, int fq) const {
        const int row0 = u.pm * 256 + wr * 64 + fr, col0 = u.pn * 256 + wc * 32 + 8 * fq;
#pragma unroll
        for (int ai = 0; ai < 2; ++ai)
#pragma unroll
            for (int m = 0; m < 4; ++m) {
                const int row = row0 + ai * 128 + m * 16; const float r = rs_of(ssq3[row]) * mul; float s = 0.f;
#pragma unroll
                for (int bj = 0; bj < 2; ++bj) {
                    const size_t off = (size_t)row * DM + col0 + bj * 128;
                    const v4u hq = *(const v4u*)(H + off);
                    const f32x4 h0 = (f32x4){bf_lo(hq.x), bf_hi(hq.x), bf_lo(hq.y), bf_hi(hq.y)}, h1 = (f32x4){bf_lo(hq.z), bf_hi(hq.z), bf_lo(hq.w), bf_hi(hq.w)};
                    const v4u pr = __builtin_nontemporal_load((const v4u*)(PROJ + off));
                    const f32x4 p0 = (f32x4){bf_lo(pr.x), bf_hi(pr.x), bf_lo(pr.y), bf_hi(pr.y)}, p1 = (f32x4){bf_lo(pr.z), bf_hi(pr.z), bf_lo(pr.w), bf_hi(pr.w)};
                    const f32x4 a0 = acc[ai][bj][m][0] * r, a1 = acc[ai][bj][m][1] * r;
                    f32x4 v0, v1;
#pragma unroll
                    for (int e = 0; e < 4; ++e) { v0[e] = h0[e] + sigmoid_f(a0[e]) * p0[e]; v1[e] = h1[e] + sigmoid_f(a1[e]) * p1[e]; }
                    acc[ai][bj][m][0] = v0; acc[ai][bj][m][1] = v1;
                    s += (v0[0] * v0[0] + v0[1] * v0[1]) + (v0[2] * v0[2] + v0[3] * v0[3]) + (v1[0] * v1[0] + v1[1] * v1[1]) + (v1[2] * v1[2] + v1[3] * v1[3]);
                }
                s += __shfl_xor(s, 16); s += __shfl_xor(s, 32);
                if (fq == 0) unsafeAtomicAdd(ssq4 + row, s);
            }
        asm volatile("s_waitcnt vmcnt(0)" ::: "memory");
        unsigned* cw = cnt + 64 * u.pm;
        if (fr == 0 && fq == 0) __hip_atomic_fetch_add(cw, 1u, __ATOMIC_RELAXED, __HIP_MEMORY_SCOPE_AGENT);
        { unsigned sp = 0; while ((unsigned)__builtin_amdgcn_readfirstlane((int)__hip_atomic_load(cw, __ATOMIC_RELAXED, __HIP_MEMORY_SCOPE_AGENT)) < 64u) { __builtin_amdgcn_s_sleep(2); if (++sp > (1u << 22)) break; } }
        asm volatile("" ::: "memory");
        f32x4 gf[2][2];
#pragma unroll
        for (int bj = 0; bj < 2; ++bj) { gf[bj][0] = *(const f32x4*)(gfin + col0 + bj * 128); gf[bj][1] = *(const f32x4*)(gfin + col0 + bj * 128 + 4); }
#pragma unroll
        for (int ai = 0; ai < 2; ++ai)
#pragma unroll
            for (int m = 0; m < 4; ++m) {
                const int row = row0 + ai * 128 + m * 16;
                const float r4 = rs_of(__hip_atomic_load(ssq4 + row, __ATOMIC_RELAXED, __HIP_MEMORY_SCOPE_AGENT));
#pragma unroll
                for (int bj = 0; bj < 2; ++bj) {
                    const size_t off = (size_t)row * DM + col0 + bj * 128;
                    *(f32x4*)(OUT + off) = acc[ai][bj][m][0] * r4 * gf[bj][0]; *(f32x4*)(OUT + off + 4) = acc[ai][bj][m][1] * r4 * gf[bj][1];
                }
            }
    }
};

struct Args { const float* in[22]; float* out; unsigned char* ws; };
struct TrDesc { const float* src; const float* gk; bf16_t* dst; int N, K, f8; };
struct TwDesc { const float* src; const float* gk; unsigned char* dst; int N, K, f8, gu; };
constexpr int TW_GU = 16 * 22, TW_WD = 44 * 8, TW_IN = 16 * 24, TW_SQ = 16 * 8, TW_PL = 2 * 8;
constexpr int TW_END_A = 4 * TW_GU, TW_END_B = TW_END_A + TW_SQ + TW_PL + TW_WD + TW_IN, TW_NITEMS = TW_END_B + TW_WD + TW_SQ;
__device__ __forceinline__ void tw_decode(const Args& a, unsigned char* ws, int it, TwDesc& d) {
    int r = it; const float* W; const float* gk = nullptr; size_t wt; int N, K, kb, nb, drow, f8 = 0, gu = 0;
    if (r < TW_END_A) {
        const int which = r / TW_GU; r -= which * TW_GU;
        kb = r / 22; nb = r % 22; N = FF; K = DM; gu = 1;
        W = a.in[which == 0 ? 3 : which == 1 ? 4 : which == 2 ? 15 : 16]; gk = a.in[which < 2 ? 2 : 14];
        wt = which < 2 ? WS_WGU1 : WS_WGU2; drow = nb * 512 + (which & 1) * 128; f8 = which >> 1;
    } else if (r < TW_END_B) {
        r -= TW_END_A;
        if (r < TW_SQ) { kb = r / 8; nb = r % 8; N = DM; K = DM; W = a.in[13]; wt = WS_WOUT; drow = nb * 256; }
        else if ((r -= TW_SQ) < TW_PL) { kb = r / 8; nb = r % 8; N = DM; K = PLE; W = a.in[20]; wt = WS_WPLE; drow = nb * 256; }
        else if ((r -= TW_PL) < TW_WD) { kb = r / 8; nb = r % 8; N = DM; K = FF; W = a.in[5]; wt = WS_WD1; drow = nb * 256; }
        else { r -= TW_WD; kb = r / 24; nb = r % 24; N = 6144; K = DM; W = a.in[7]; gk = a.in[6]; const int n0 = nb * 256;
            wt = WS_WIN; drow = n0;
            if (n0 >= 3072) drow = n0 - 1024; else if (n0 >= 2048) { wt = WS_WINV; drow = n0 - 2048; } }
    } else {
        r -= TW_END_B;
        if (r < TW_WD) { kb = r / 8; nb = r % 8; N = DM; K = FF; W = a.in[17]; wt = WS_WD2; drow = nb * 256; f8 = 1; }
        else { r -= TW_WD; kb = r / 8; nb = r % 8; N = DM; K = DM; W = a.in[19]; gk = a.in[18]; wt = WS_WGATE; drow = nb * 256; }
    }
    const int k0 = kb * 128, n0 = nb * 256;
    d.src = W + (size_t)k0 * N + n0; d.gk = gk ? gk + k0 : nullptr; d.N = N; d.K = K; d.f8 = f8; d.gu = gu;
    d.dst = ws + wt + ((size_t)drow * K + k0) * (f8 ? 1 : 2);
}
__device__ __forceinline__ void tw_range(const Args& a, unsigned char* ws, LAS unsigned char* lds, int wave, int lane, int lo, int hi, int w, int nw) {
    LAS float* img = (LAS float*)lds;
    f32x4 v[16]; TwDesc cur; int it = lo + w;
    if (it < hi) { tw_decode(a, ws, it, cur);
#pragma unroll
        for (int j = 0; j < 16; ++j) v[j] = __builtin_nontemporal_load((const f32x4*)(cur.src + (size_t)(wave * 16 + j) * cur.N + lane * 4)); }
    const int tid = wave * 64 + lane;
    while (it < hi) {
        __syncthreads();
#pragma unroll
        for (int j = 0; j < 16; ++j) { const int k = wave * 16 + j; const float g = cur.gk ? cur.gk[k] : 1.0f;
            *(LAS f32x4*)(img + k * 256 + ((lane * 4) ^ (((k >> 3) & 15) << 2))) = v[j] * g; }
        const int itn = it + nw; TwDesc nxt = cur;
        if (itn < hi) { tw_decode(a, ws, itn, nxt);
#pragma unroll
            for (int j = 0; j < 16; ++j) v[j] = __builtin_nontemporal_load((const f32x4*)(nxt.src + (size_t)(wave * 16 + j) * nxt.N + lane * 4)); }
        __syncthreads();
#pragma unroll
        for (int q8 = 0; q8 < 8; ++q8) { const int q = tid + 512 * q8, c = q & 15, n = q >> 4;
            const LAS float* sp = img + (8 * c) * 256 + (n ^ (c << 2));
            const float s0 = sp[0], s1 = sp[256], s2 = sp[512], s3 = sp[768], s4 = sp[1024], s5 = sp[1280], s6 = sp[1536], s7 = sp[1792];
            const size_t row = (size_t)(n + (cur.gu ? (n >> 7) * 128 : 0));
            if (cur.f8) {
                int w0 = __builtin_amdgcn_cvt_pk_fp8_f32(f8_clamp(s0 * WD_SCALE), f8_clamp(s1 * WD_SCALE), 0, false); w0 = __builtin_amdgcn_cvt_pk_fp8_f32(f8_clamp(s2 * WD_SCALE), f8_clamp(s3 * WD_SCALE), w0, true);
                int w1 = __builtin_amdgcn_cvt_pk_fp8_f32(f8_clamp(s4 * WD_SCALE), f8_clamp(s5 * WD_SCALE), 0, false); w1 = __builtin_amdgcn_cvt_pk_fp8_f32(f8_clamp(s6 * WD_SCALE), f8_clamp(s7 * WD_SCALE), w1, true);
                v2u o; o.x = (unsigned)w0; o.y = (unsigned)w1;
                *(v2u*)(cur.dst + row * cur.K + 8 * c) = o;
            } else {
                v4u o; o.x = cvt_pk_bf16(s0, s1); o.y = cvt_pk_bf16(s2, s3); o.z = cvt_pk_bf16(s4, s5); o.w = cvt_pk_bf16(s6, s7);
                *(v4u*)(cur.dst + (row * cur.K + 8 * c) * 2) = o; } }
        cur = nxt; it = itn;
    }
    __syncthreads();
}
__device__ __forceinline__ void tr_idle(const Args& a, unsigned char* ws, LAS unsigned char* lds, int wave, int bid, int G, int nwg, int lo, int hi) {
    const int rem = nwg % G, first = rem, nblk = G - rem;
    if (bid >= first) tw_range(a, ws, lds, wave, pg8::lane_id_v(), lo, hi, bid - first, nblk);
}
__device__ __forceinline__ void conv_ldx(const bf16_t* Grow, int ch, bool valid, float (&x)[8]) {
    if (valid) { const v4u a = __builtin_nontemporal_load((const v4u*)(Grow + 1024 + ch)), b = __builtin_nontemporal_load((const v4u*)(Grow + 2048 + ch));
        x[0] = bf_lo(a.x) * bf_lo(b.x); x[1] = bf_hi(a.x) * bf_hi(b.x); x[2] = bf_lo(a.y) * bf_lo(b.y); x[3] = bf_hi(a.y) * bf_hi(b.y);
        x[4] = bf_lo(a.z) * bf_lo(b.z); x[5] = bf_hi(a.z) * bf_hi(b.z); x[6] = bf_lo(a.w) * bf_lo(b.w); x[7] = bf_hi(a.w) * bf_hi(b.w); }
    else {
#pragma unroll
        for (int e = 0; e < 8; ++e) x[e] = 0.f; }
}

__global__ void __launch_bounds__(512, 2) mk_fwd(Args a) {
    extern __shared__ __attribute__((aligned(16))) unsigned char lds_raw[];
    LAS unsigned char* lds = (LAS unsigned char*)lds_raw;
    cg::grid_group grid = cg::this_grid();
    const int wave = __builtin_amdgcn_readfirstlane((int)threadIdx.x >> 6);
#define LANE_TID() const int lane = pg8::lane_id_v(), tid = wave * 64 + lane; (void)tid
    const int G = gridDim.x, bid = blockIdx.x, gw = bid * 8 + wave, NGW = G * 8;
    unsigned char* ws = a.ws;
    const float* x = a.in[0]; float* out = a.out;
    float* ssq0 = (float*)(ws + WS_SSQ); float* ssq1 = ssq0 + MTOK; float* ssq2 = ssq1 + MTOK; float* ssq3 = ssq2 + MTOK; float* ssq4 = ssq3 + MTOK;
    bf16_t* WGU1 = (bf16_t*)(ws + WS_WGU1); bf16_t* WD1 = (bf16_t*)(ws + WS_WD1); bf16_t* WIN = (bf16_t*)(ws + WS_WIN); bf16_t* WINV = (bf16_t*)(ws + WS_WINV);
    bf16_t* WOUT = (bf16_t*)(ws + WS_WOUT); bf16_t* WGU2 = (bf16_t*)(ws + WS_WGU2); bf16_t* WD2 = (bf16_t*)(ws + WS_WD2); bf16_t* WGATE = (bf16_t*)(ws + WS_WGATE);
    bf16_t* WPLE = (bf16_t*)(ws + WS_WPLE); bf16_t* HB = (bf16_t*)(ws + WS_HB); bf16_t* PB = (bf16_t*)(ws + WS_PB); unsigned char* ACT = ws + WS_ACT;
    bf16_t* QK = (bf16_t*)(ws + WS_QK); bf16_t* VT = (bf16_t*)(ws + WS_VT); bf16_t* MIX = (bf16_t*)(ws + WS_MIX); bf16_t* GB = (bf16_t*)(ws + WS_G); bf16_t* PROJ = (bf16_t*)(ws + WS_PROJ);

    unsigned* barw = (unsigned*)(ws + WS_BAR); unsigned* pcnt = (unsigned*)(ssq4 + MTOK);
    volatile LAS unsigned* MISC = (volatile LAS unsigned*)(lds + LDS_MISC);
    { LANE_TID(); if (tid < 2) MISC[tid] = 0u; }
    const XcdBarrier bar = xcd_barrier_post(barw, MISC, wave == 0 && pg8::lane_id_v() == 0);
    if (gridDim.y == 0x7fffu) grid.sync();
    {
        LANE_TID();
        for (int i = bid * 512 + tid; i < 4 * MTOK + 32 * 64; i += G * 512) ssq1[i] = 0.f;
        for (int row = gw; row < MTOK; row += NGW) {
            const f32x4* xr = (const f32x4*)(x + (size_t)row * DM) + lane;
            f32x4 v[8]; float s = 0.f;
#pragma unroll
            for (int j = 0; j < 8; ++j) { v[j] = __builtin_nontemporal_load(xr + 64 * j); s += (v[j][0] * v[j][0] + v[j][1] * v[j][1]) + (v[j][2] * v[j][2] + v[j][3] * v[j][3]); }
            s = wave_sum(s);
            if (lane == 0) ssq0[row] = s;
            v2u* o = (v2u*)(HB + (size_t)row * DM) + lane;
#pragma unroll
            for (int j = 0; j < 8; ++j) { v2u w; w.x = cvt_pk_bf16(v[j][0], v[j][1]); w.y = cvt_pk_bf16(v[j][2], v[j][3]); o[64 * j] = w; }
            const f32x4 pv = __builtin_nontemporal_load((const f32x4*)(a.in[1] + (size_t)row * PLE) + lane);
            v2u pw; pw.x = cvt_pk_bf16(pv[0], pv[1]); pw.y = cvt_pk_bf16(pv[2], pv[3]);
            ((v2u*)(PB + (size_t)row * PLE))[lane] = pw;
        }
        tw_range(a, ws, lds, wave, lane, 0, 2 * TW_GU, bid, G);
    }
    xcd_barrier(bar, wave == 0 && pg8::lane_id_v() == 0);
    { pg8::Gemm g{HB, WGU1, MTOK, 2 * FF, DM}; pg8::StaticOrder S; S.init(MTOK, 2 * FF, G, bid); EpiSwiGLU<false> E{ACT, ssq0, 1.0f};
      pg8::gemm_phase<EpiSwiGLU<false>, pg8::StaticOrder, true, true>(lds, g, S, E, wave); }
    tr_idle(a, ws, lds, wave, bid, G, (MTOK / 256) * (2 * FF / 256), TW_END_A, TW_END_B);
    xcd_barrier(bar, wave == 0 && pg8::lane_id_v() == 0);
    { pg8::Gemm g{(const bf16_t*)ACT, WD1, MTOK, DM, FF}; pg8::StaticOrder S; S.init(MTOK, DM, G, bid); EpiResidL<false> E{HB, nullptr, ssq1, 0.5f};
      pg8::gemm_phase<EpiResidL<false>, pg8::StaticOrder, true, true, false>(lds, g, S, E, wave); }
    xcd_barrier(bar, wave == 0 && pg8::lane_id_v() == 0);
    { pg8::Gemm g{HB, WIN, MTOK, 5120, DM}; pg8::StaticOrder S; S.init(MTOK, 5120, G, bid); EpiWin E{QK, GB, ssq1};
      pg8::gemm_phase<EpiWin, pg8::StaticOrder, true, true>(lds, g, S, E, wave); }
    { pg8::Gemm g{WINV, HB, 1024, MTOK, DM}; pg8::StaticOrder S; S.init(1024, MTOK, G, (bid + G / 2) % G); EpiCol E{VT, MTOK, ssq1};
      pg8::gemm_phase<EpiCol, pg8::StaticOrder, true, true>(lds, g, S, E, wave); }
    xcd_barrier(bar, wave == 0 && pg8::lane_id_v() == 0);
    {
        LANE_TID();
        tw_range(a, ws, lds, wave, lane, 2 * TW_GU, 4 * TW_GU, bid, G);
        LAS float* rpb_l = (LAS float*)lds;
        LAS unsigned char* ring = lds + 15360;
        constexpr int SLOT = 18432;
        for (int i = tid; i < 8 * 15 * 31; i += 512) rpb_l[i] = a.in[8][i];
        __syncthreads();
        const bf16_t* QH = QK; const bf16_t* KH = QK + QK_STRIDE;
        const float* g_attn = a.in[11];
        const int j16 = lane & 15, kq = lane >> 4;
        const int kdst = (tid >> 4) * 272 + (tid & 15) * 16, vdst = (tid >> 3) * 144 + (tid & 7) * 16;
        for (int Wu = bid; Wu < 512; Wu += G) {
            const int xcd = Wu & 7, rp = (Wu >> 3) & 31, iter = Wu >> 8, bh = 2 * xcd + iter;
            const int r = 2 * rp + (wave >> 2), cb = wave & 3, b = bh >> 3, h = bh & 7;
            const int rsU = min(max(2 * rp - 4, 0), 56), rs = min(max(r - 4, 0), 56), dsh = rs - rsU, nU = min(max(2 * rp - 3, 0), 56) + 8 - rsU;
            const int kc0 = (cb == 0) ? 0 : (cb == 1) ? 8 : (cb == 2) ? 24 : 32;
            const size_t bhbase = (size_t)(b * 8 + h) * 4096;
            v4u kr[9][2];
            const unsigned char* Kg = (const unsigned char*)(KH + (bhbase + rsU * 64) * 128) + tid * 16;
#pragma unroll
            for (int j = 0; j < 9; ++j) if (j < nU) { kr[j][0] = *(const v4u*)(Kg + j * 16384); kr[j][1] = *(const v4u*)(Kg + j * 16384 + 8192); }
            const bf16_t* Qp = QH + (bhbase + r * 64 + cb * 16 + j16) * 128 + 8 * kq;
            bf16x8 qf[4];
#pragma unroll
            for (int ks = 0; ks < 4; ++ks) qf[ks] = *(const bf16x8*)(Qp + 32 * ks);
            *(LAS v4u*)(ring + kdst) = kr[0][0]; *(LAS v4u*)(ring + kdst + 32 * 272) = kr[0][1];
            asm volatile("s_waitcnt lgkmcnt(0)" ::: "memory"); __builtin_amdgcn_s_barrier(); asm volatile("" ::: "memory");
            const int koff = (kc0 + 8 * (j16 >> 2) + (j16 & 3)) * 272 + kq * 16;
            f32x4 sc[8][2];
#define ATT_S(I, BUF) do { bf16x8 k0_[4], k1_[4]; _Pragma("unroll") for (int ks = 0; ks < 4; ++ks) { k0_[ks] = *(const LAS bf16x8*)((BUF) + koff + ks * 64); k1_[ks] = *(const LAS bf16x8*)((BUF) + koff + 4 * 272 + ks * 64); } \
                f32x4 s0_ = (f32x4){0.f, 0.f, 0.f, 0.f}, s1_ = (f32x4){0.f, 0.f, 0.f, 0.f}; \
                _Pragma("unroll") for (int ks = 0; ks < 4; ++ks) { s0_ = __builtin_amdgcn_mfma_f32_16x16x32_bf16(k0_[ks], qf[ks], s0_, 0, 0, 0); s1_ = __builtin_amdgcn_mfma_f32_16x16x32_bf16(k1_[ks], qf[ks], s1_, 0, 0, 0); } \
                sc[I][0] = s0_; sc[I][1] = s1_; } while (0)
#pragma unroll
            for (int t = 0; t < 9; ++t) if (t < nU) {
                const LAS unsigned char* buf = ring + (t & 1) * SLOT;
                if (dsh == 0) { if (t < 8) ATT_S(t < 8 ? t : 0, buf); } else { if (t >= 1) ATT_S(t >= 1 ? t - 1 : 0, buf); }
                if (t + 1 < nU) { LAS unsigned char* nb = ring + ((t + 1) & 1) * SLOT; *(LAS v4u*)(nb + kdst) = kr[t + 1 < 9 ? t + 1 : 8][0]; *(LAS v4u*)(nb + kdst + 32 * 272) = kr[t + 1 < 9 ? t + 1 : 8][1]; }
                asm volatile("s_waitcnt lgkmcnt(0)" ::: "memory"); __builtin_amdgcn_s_barrier(); asm volatile("" ::: "memory");
            }
#undef ATT_S
            const unsigned char* Vg = (const unsigned char*)(VT + (size_t)(h * 128 + (tid >> 3)) * MTOK + b * 4096 + rsU * 64) + (tid & 7) * 16;
#pragma unroll
            for (int j = 0; j < 9; ++j) if (j < nU) { kr[j][0] = *(const v4u*)(Vg + j * 128); kr[j][1] = *(const v4u*)(Vg + j * 128 + (size_t)64 * MTOK * 2); }
            const int c = cb * 16 + j16, cs = min(max(c - 8, 0), 48);
            const float scale = 0.08838834764831845f;
            const LAS float* bl = rpb_l + h * 465 + (rs - r + 7) * 31;
            float mx = -3.0e38f;
#pragma unroll
            for (int i = 0; i < 8; ++i)
#pragma unroll
                for (int tl = 0; tl < 2; ++tl)
#pragma unroll
                    for (int t = 0; t < 4; ++t) {
                        const int kc = kc0 + 8 * kq + 4 * tl + t; const bool inw = (kc >= cs) && (kc < cs + 16);
                        const int rel = min(max(kc - c + 15, 0), 30);
                        float v = sc[i][tl][t] * scale + bl[i * 31 + rel]; v = inw ? v : -1e30f; sc[i][tl][t] = v; mx = fmaxf(mx, v);
                    }
            mx = fmaxf(mx, __shfl_xor(mx, 16)); mx = fmaxf(mx, __shfl_xor(mx, 32));
            float sum = 0.f;
#pragma unroll
            for (int i = 0; i < 8; ++i)
#pragma unroll
                for (int tl = 0; tl < 2; ++tl)
#pragma unroll
                    for (int t = 0; t < 4; ++t) { const float pe = __builtin_amdgcn_exp2f((sc[i][tl][t] - mx) * 1.4426950408889634f); sc[i][tl][t] = pe; sum += pe; }
            sum += __shfl_xor(sum, 16); sum += __shfl_xor(sum, 32);
            f32x4 oacc[8];
#pragma unroll
            for (int dt = 0; dt < 8; ++dt) oacc[dt] = (f32x4){0.f, 0.f, 0.f, 0.f};
            *(LAS v4u*)(ring + vdst) = kr[0][0]; *(LAS v4u*)(ring + vdst + 64 * 144) = kr[0][1];
            asm volatile("s_waitcnt lgkmcnt(0)" ::: "memory"); __builtin_amdgcn_s_barrier(); asm volatile("" ::: "memory");
            const int voff = j16 * 144 + (kc0 + 8 * kq) * 2;
#define ATT_PV(I, BUF) do { u32x4 pw_; pw_.x = cvt_pk_bf16(sc[I][0][0], sc[I][0][1]); pw_.y = cvt_pk_bf16(sc[I][0][2], sc[I][0][3]); pw_.z = cvt_pk_bf16(sc[I][1][0], sc[I][1][1]); pw_.w = cvt_pk_bf16(sc[I][1][2], sc[I][1][3]); \
                const bf16x8 pf_ = __builtin_bit_cast(bf16x8, pw_); \
                _Pragma("unroll") for (int dt = 0; dt < 8; ++dt) { const bf16x8 vf_ = *(const LAS bf16x8*)((BUF) + voff + dt * 16 * 144); oacc[dt] = __builtin_amdgcn_mfma_f32_16x16x32_bf16(vf_, pf_, oacc[dt], 0, 0, 0); } } while (0)
#pragma unroll
            for (int t = 0; t < 9; ++t) if (t < nU) {
                const LAS unsigned char* buf = ring + (t & 1) * SLOT;
                if (dsh == 0) { if (t < 8) ATT_PV(t < 8 ? t : 0, buf); } else { if (t >= 1) ATT_PV(t >= 1 ? t - 1 : 0, buf); }
                if (t + 1 < nU) { LAS unsigned char* nb = ring + ((t + 1) & 1) * SLOT; *(LAS v4u*)(nb + vdst) = kr[t + 1 < 9 ? t + 1 : 8][0]; *(LAS v4u*)(nb + vdst + 64 * 144) = kr[t + 1 < 9 ? t + 1 : 8][1]; }
                asm volatile("s_waitcnt lgkmcnt(0)" ::: "memory"); __builtin_amdgcn_s_barrier(); asm volatile("" ::: "memory");
            }
#undef ATT_PV
            const float inv = 1.f / sum; float ss = 0.f;
#pragma unroll
            for (int dt = 0; dt < 8; ++dt) { oacc[dt] = oacc[dt] * inv; ss += (oacc[dt][0] * oacc[dt][0] + oacc[dt][1] * oacc[dt][1]) + (oacc[dt][2] * oacc[dt][2] + oacc[dt][3] * oacc[dt][3]); }
            ss += __shfl_xor(ss, 16); ss += __shfl_xor(ss, 32);
            const float rn = rsqrtf(ss * (1.f / 128.f) + EPS);
            bf16_t* Op = MIX + (size_t)(b * 4096 + r * 64 + c) * DM + h * 128 + 4 * kq;
#pragma unroll
            for (int dt = 0; dt < 8; ++dt) { const f32x4 gn = *(const f32x4*)(g_attn + h * 128 + 16 * dt + 4 * kq); const f32x4 o = oacc[dt] * rn * gn;
                v2u w; w.x = cvt_pk_bf16(o[0], o[1]); w.y = cvt_pk_bf16(o[2], o[3]); *(v2u*)(Op + 16 * dt) = w; }
        }
        for (int it = gw; it < 2048; it += NGW) {
            const int half = it & 1, row0 = (it >> 1) * 8, ch = half * 512 + lane * 8;
            float w0[8], w1[8], w2[8], bb[8], gn[8];
#pragma unroll
            for (int q = 0; q < 2; ++q) {
                const f32x4 t0 = *(const f32x4*)(a.in[9] + ch + 4 * q), t1 = *(const f32x4*)(a.in[9] + 1024 + ch + 4 * q), t2 = *(const f32x4*)(a.in[9] + 2048 + ch + 4 * q);
                const f32x4 t3 = *(const f32x4*)(a.in[10] + ch + 4 * q), t4 = *(const f32x4*)(a.in[12] + ch + 4 * q);
#pragma unroll
                for (int e = 0; e < 4; ++e) { w0[4 * q + e] = t0[e]; w1[4 * q + e] = t1[e]; w2[4 * q + e] = t2[e]; bb[4 * q + e] = t3[e]; gn[4 * q + e] = t4[e]; }
            }
            const bf16_t* Gr = GB + (size_t)row0 * NGRP;
            float xp[8], xc[8], xn[8];
            conv_ldx(Gr - NGRP, ch, (row0 & 4095) != 0, xp);
            conv_ldx(Gr, ch, true, xc);
#pragma unroll
            for (int tk = 0; tk < 8; ++tk) {
                const int row = row0 + tk;
                conv_ldx(Gr + (size_t)(tk + 1) * NGRP, ch, (row & 4095) != 4095, xn);
                const v4u gbv = __builtin_nontemporal_load((const v4u*)(Gr + (size_t)tk * NGRP + ch));
                float gbf[8] = {bf_lo(gbv.x), bf_hi(gbv.x), bf_lo(gbv.y), bf_hi(gbv.y), bf_lo(gbv.z), bf_hi(gbv.z), bf_lo(gbv.w), bf_hi(gbv.w)};
                float y[8]; float ss = 0.f;
#pragma unroll
                for (int e = 0; e < 8; ++e) { y[e] = gbf[e] * (w0[e] * xp[e] + w1[e] * xc[e] + w2[e] * xn[e] + bb[e]); ss += y[e] * y[e]; }
                ss += __shfl_xor(ss, 1); ss += __shfl_xor(ss, 2); ss += __shfl_xor(ss, 4); ss += __shfl_xor(ss, 8);
                const float rn = rsqrtf(ss * (1.f / 128.f) + EPS);
                v4u w; w.x = cvt_pk_bf16(y[0] * rn * gn[0], y[1] * rn * gn[1]); w.y = cvt_pk_bf16(y[2] * rn * gn[2], y[3] * rn * gn[3]);
                w.z = cvt_pk_bf16(y[4] * rn * gn[4], y[5] * rn * gn[5]); w.w = cvt_pk_bf16(y[6] * rn * gn[6], y[7] * rn * gn[7]);
                *(v4u*)(MIX + (size_t)row * DM + 1024 + ch) = w;
#pragma unroll
                for (int e = 0; e < 8; ++e) { xp[e] = xc[e]; xc[e] = xn[e]; }
            }
        }
        __syncthreads();
    }
    xcd_barrier(bar, wave == 0 && pg8::lane_id_v() == 0);
    { pg8::Gemm g{MIX, WOUT, MTOK, DM, DM}; pg8::StaticOrder S; S.init(MTOK, DM, G, bid); EpiResidL<true> E{HB, ws + WS_HB8, ssq2, 1.0f};
      pg8::gemm_phase<EpiResidL<true>, pg8::StaticOrder, true, true>(lds, g, S, E, wave); }
    { pg8::Gemm g{PB, WPLE, MTOK, DM, PLE}; pg8::StaticOrder S; S.init(MTOK, DM, G, bid); EpiCol E{PROJ, DM, nullptr};
      pg8::gemm_phase<EpiCol, pg8::StaticOrder, true, true>(lds, g, S, E, wave); }
    xcd_barrier(bar, wave == 0 && pg8::lane_id_v() == 0);
    { pg8::Gemm g{(const bf16_t*)(ws + WS_HB8), WGU2, MTOK, 2 * FF, DM / 2}; pg8::StaticOrder S; S.init(MTOK, 2 * FF, G, bid); EpiSwiGLU<true> E{ACT, ssq2, 1.0f / (H_SCALE * WD_SCALE)};
      pg8::gemm_phase<EpiSwiGLU<true>, pg8::StaticOrder, true, true, true>(lds, g, S, E, wave); }
    tr_idle(a, ws, lds, wave, bid, G, (MTOK / 256) * (2 * FF / 256), TW_END_B, TW_NITEMS);
    xcd_barrier(bar, wave == 0 && pg8::lane_id_v() == 0);
    { pg8::Gemm g{(const bf16_t*)ACT, WD2, MTOK, DM, FF / 2}; pg8::StaticOrder S; S.init(MTOK, DM, G, bid); EpiResidL<false> E{HB, nullptr, ssq3, 0.5f / (ACT_SCALE * WD_SCALE)};
      pg8::gemm_phase<EpiResidL<false>, pg8::StaticOrder, true, true, true>(lds, g, S, E, wave); }
    xcd_barrier(bar, wave == 0 && pg8::lane_id_v() == 0);
    { pg8::Gemm g{HB, WGATE, MTOK, DM, DM}; pg8::StaticOrder S; S.init(MTOK, DM, G, bid, 4); EpiPleNorm E{HB, out, PROJ, ssq3, ssq4, pcnt, a.in[21], 1.0f};
      pg8::gemm_phase<EpiPleNorm, pg8::StaticOrder, true, true, false>(lds, g, S, E, wave); }
}

extern "C" void kernel_launch(void* const* d_in, const int* in_sizes, int n_in, void* d_out, int out_size, void* d_ws, size_t ws_size, hipStream_t stream) {
    static int grid = 0;
    if (grid == 0) {
        if (n_in != 22 || out_size != MTOK * DM || ws_size < WS_END) { fprintf(stderr, "kernel_launch: unexpected shapes (n_in %d out %d ws %zu)\n", n_in, out_size, ws_size); grid = -1; return; }
        int dev = 0, cus = 0, per_cu = 0;
        (void)hipGetDevice(&dev);
        (void)hipDeviceGetAttribute(&cus, hipDeviceAttributeMultiprocessorCount, dev);
        (void)hipFuncSetAttribute((const void*)mk_fwd, hipFuncAttributeMaxDynamicSharedMemorySize, LDS_BYTES);
        (void)hipOccupancyMaxActiveBlocksPerMultiprocessor(&per_cu, (const void*)mk_fwd, 512, LDS_BYTES);
        (void)hipGetLastError();
        grid = cus > 0 ? cus : 256;
    }
    if (grid < 0) return;
    if (hipMemsetAsync((unsigned char*)d_ws + WS_BAR, 0, XCD_BAR_WORDS * 4, stream) != hipSuccess) { fprintf(stderr, "kernel_launch: memset of the barrier words failed\n"); return; }
    Args a{};
    for (int i = 0; i < 22; ++i) a.in[i] = (const float*)d_in[i];
    a.out = (float*)d_out; a.ws = (unsigned char*)d_ws;
    void* args[] = {&a};
    hipError_t e = hipLaunchCooperativeKernel((const void*)mk_fwd, dim3(grid), dim3(512), args, LDS_BYTES, stream);
    if (e != hipSuccess) fprintf(stderr, "cooperative launch failed: %s (grid %d)\n", hipGetErrorString(e), grid);
}
```

```cpp
#include <hip/hip_runtime.h>
#include <hip/hip_cooperative_groups.h>
#include <cstdio>
#include <cstdint>
namespace cg = cooperative_groups;
namespace pg8 {
#define PG8_LAS __attribute__((address_space(3)))
typedef unsigned short bf16_t;
typedef short bf16x8 __attribute__((ext_vector_type(8)));
typedef float f32x4 __attribute__((ext_vector_type(4)));
typedef unsigned u32x4 __attribute__((ext_vector_type(4)));
constexpr int BM = 256, BK = 64, HALF = 128, HTB = HALF * BK * 2  , STAGE_BYTES = 8 * HTB, NXCD = 8, WGM = 8;

__host__ __device__ __forceinline__ int lds_byte(int r, int c) { const int st = (r >> 4) * 2 + (c >> 5), rr = r & 15, cc = c & 31, ob = rr * 64 + cc * 2; return st * 1024 + (ob ^ (((ob >> 9) & 1) << 5)); }
__host__ __device__ __forceinline__ void stage_rc(int b, int& R, int& C) { const int st = b / 1024, sb = b % 1024, swz = sb ^ (((sb >> 9) & 1) << 5); R = (st >> 1) * 16 + swz / 64; C = (st & 1) * 32 + (swz % 64) / 2; }
__host__ __device__ __forceinline__ int perm32(int rho) { const int n = rho >> 4, i = rho & 15; return 8 * (i >> 2) + 4 * n + (i & 3); }

struct Unit { int pm, pn; };
struct Gemm { const bf16_t* A; const bf16_t* Bt; int M, N, K; };

struct StaticOrder {
    int nM, nN, nwg, G, c;
    __host__ __device__ void init(int M, int N, int G_, int c_) { nM = M / BM; nN = N / BM; nwg = nM * nN; G = G_; c = c_; }
    __host__ __device__ bool next(int i, Unit& u) const {
        const long L = (long)i * G + c; if (L >= nwg) return false;
        int wgid = (int)L; { const int q = nwg / NXCD, r = nwg % NXCD, xcd = wgid % NXCD, off = wgid / NXCD; wgid = (xcd < r ? xcd * (q + 1) : r * (q + 1) + (xcd - r) * q) + off; }
        const int nig = WGM * nN, gid = wgid / nig, fm = gid * WGM, gsz = (nM - fm) < WGM ? (nM - fm) : WGM;
        u.pm = fm + ((wgid % nig) % gsz); u.pn = (wgid % nig) / gsz; return true;
    }
    __device__ __forceinline__ void a_ready(const Unit&) const {}
    __device__ __forceinline__ void done(const Unit&) const {}
};

__device__ __forceinline__ unsigned cvt_pk_bf16(float lo, float hi) { unsigned r; asm volatile("v_cvt_pk_bf16_f32 %0, %1, %2" : "=v"(r) : "v"(lo), "v"(hi)); return r; }
__device__ __forceinline__ int lane_id_v() { int l; asm volatile("v_mbcnt_lo_u32_b32 %0, -1, 0\n\tv_mbcnt_hi_u32_b32 %0, -1, %0" : "=v"(l)); return l; }
typedef int i32x4v __attribute__((ext_vector_type(4)));
typedef int i32x8v __attribute__((ext_vector_type(8)));
template <class Epi, class Sched, bool ALIGN_EPI = false, bool SP2 = false, bool FP8 = false>
__device__ __forceinline__ void gemm_phase(PG8_LAS unsigned char* lds, const Gemm g, const Sched& S, const Epi& E, const int wid  ) {
    const int lane = lane_id_v(), tid = wid * 64 + lane, wr = wid >> 2, wc = wid & 3, fr = lane & 15, fq = lane >> 4;
    int sc1 = 0x7F7F7F7F; asm volatile("" : "+v"(sc1));
    const int K = g.K, nt = K / BK;
    unsigned voffA[2], voffB[2];
#pragma unroll
    for (int i = 0; i < 2; ++i) { int R, C; stage_rc(tid * 16 + i * 8192, R, C); const int Rb = Epi::PERM ? ((R & ~31) + perm32(R & 31)) : R;
        voffA[i] = (unsigned)(R * K + C) * 2u; voffB[i] = (unsigned)(Rb * K + C) * 2u; }
    const size_t kstep = (size_t)(BK * 2);
    size_t hstep = (size_t)HALF * K * 2;
    const size_t tstep = 2 * hstep;
    const unsigned ldsw = (unsigned)wid * 1024u;
    const int aoff = lds_byte(wr * 64 + fr, fq * 8), boff = lds_byte(wc * 32 + fr, fq * 8);
#define PG8_SA(b, h) (((b) * 2 + (h)) * HTB)
#define PG8_SB(b, h) ((4 + (b) * 2 + (h)) * HTB)
#define PG8_STAGE(bufoff, gbase, voff) do { _Pragma("unroll") for (int _i = 0; _i < 2; ++_i) \
        __builtin_amdgcn_global_load_lds((const unsigned*)((const char*)(gbase) + (voff)[_i]), (PG8_LAS unsigned*)(lds + (bufoff) + ldsw + _i * 8192), 16, 0, 0); } while (0)
#define PG8_LDA(dst, b, h) do { if constexpr (FP8) { _Pragma("unroll") for (int m = 0; m < 4; ++m) { const i32x4v lo_ = *(const PG8_LAS i32x4v*)(lds + PG8_SA(b, h) + aoff + m * 2048), hi_ = *(const PG8_LAS i32x4v*)(lds + PG8_SA(b, h) + aoff + m * 2048 + 1024); dst##8[m] = __builtin_shufflevector(lo_, hi_, 0, 1, 2, 3, 4, 5, 6, 7); } } else { \
        _Pragma("unroll") for (int m = 0; m < 4; ++m) _Pragma("unroll") for (int k = 0; k < 2; ++k) dst[m][k] = *(const PG8_LAS bf16x8*)(lds + PG8_SA(b, h) + aoff + m * 2048 + k * 1024); } } while (0)
#define PG8_LDB(dst, b, h) do { if constexpr (FP8) { _Pragma("unroll") for (int n = 0; n < 2; ++n) { const i32x4v lo_ = *(const PG8_LAS i32x4v*)(lds + PG8_SB(b, h) + boff + n * 2048), hi_ = *(const PG8_LAS i32x4v*)(lds + PG8_SB(b, h) + boff + n * 2048 + 1024); dst##8[n] = __builtin_shufflevector(lo_, hi_, 0, 1, 2, 3, 4, 5, 6, 7); } } else { \
        _Pragma("unroll") for (int n = 0; n < 2; ++n) _Pragma("unroll") for (int k = 0; k < 2; ++k) dst[n][k] = *(const PG8_LAS bf16x8*)(lds + PG8_SB(b, h) + boff + n * 2048 + k * 1024); } } while (0)
#define PG8_MMA(ai, bj, Af, Bf) do { __builtin_amdgcn_s_setprio(1); if constexpr (FP8) { _Pragma("unroll") for (int m = 0; m < 4; ++m) _Pragma("unroll") for (int n = 0; n < 2; ++n) \
        asm volatile("v_mfma_scale_f32_16x16x128_f8f6f4 %0, %1, %2, %0, %3, %3 op_sel_hi:[0,0,0]" : "+v"(acc[ai][bj][m][n]) : "v"(Bf##8[n]), "v"(Af##8[m]), "v"(sc1)); } else { \
        _Pragma("unroll") for (int m = 0; m < 4; ++m) _Pragma("unroll") for (int n = 0; n < 2; ++n) _Pragma("unroll") for (int k = 0; k < 2; ++k) \
        acc[ai][bj][m][n] = __builtin_amdgcn_mfma_f32_16x16x32_bf16(Bf[n][k], Af[m][k], acc[ai][bj][m][n], 0, 0, 0); } __builtin_amdgcn_s_setprio(0); } while (0)
#define PG8_WAIT_V(n) asm volatile("s_waitcnt vmcnt(" #n ")" ::: "memory")
#define PG8_WAIT_L(n) asm volatile("s_waitcnt lgkmcnt(" #n ")" ::: "memory")
#define PG8_BAR __builtin_amdgcn_s_barrier()
#define PG8_SCHED __builtin_amdgcn_sched_barrier(0)
    Unit cur, nxt; int ui = 0;
    if (!S.next(0, cur)) return;
    f32x4 acc[2][2][4][2];
#pragma unroll
    for (int a = 0; a < 2; ++a)
#pragma unroll
        for (int b = 0; b < 2; ++b)
#pragma unroll
            for (int m = 0; m < 4; ++m)
#pragma unroll
                for (int n = 0; n < 2; ++n) acc[a][b][m][n] = (f32x4){0.f, 0.f, 0.f, 0.f};
    bf16x8 At[4][2], B0[2][2], B1[2][2]; i32x8v At8[4], B08[2], B18[2];
    const char* cA = (const char*)g.A + (size_t)cur.pm * tstep; const char* cB = (const char*)g.Bt + (size_t)cur.pn * tstep;
    S.a_ready(cur);
    if constexpr (SP2) {
        PG8_STAGE(PG8_SB(0, 0), cB, voffB); PG8_STAGE(PG8_SB(0, 1), cB + hstep, voffB); PG8_STAGE(PG8_SA(0, 0), cA, voffA); PG8_STAGE(PG8_SA(0, 1), cA + hstep, voffA);
        if (wr == 1) PG8_BAR;
        PG8_WAIT_V(2); PG8_BAR;
        PG8_STAGE(PG8_SB(1, 0), cB + kstep, voffB); PG8_STAGE(PG8_SA(1, 0), cA + kstep, voffA); PG8_STAGE(PG8_SB(1, 1), cB + hstep + kstep, voffB);
        PG8_WAIT_V(6); PG8_BAR;
    } else {
        PG8_STAGE(PG8_SB(0, 0), cB, voffB); PG8_STAGE(PG8_SA(0, 0), cA, voffA); PG8_STAGE(PG8_SB(0, 1), cB + hstep, voffB); PG8_STAGE(PG8_SA(0, 1), cA + hstep, voffA);
        if (wr == 1) PG8_BAR;
        PG8_WAIT_V(4); PG8_BAR;
        PG8_STAGE(PG8_SB(1, 0), cB + kstep, voffB); PG8_STAGE(PG8_SA(1, 0), cA + kstep, voffA); PG8_STAGE(PG8_SB(1, 1), cB + hstep + kstep, voffB);
        PG8_WAIT_V(6); PG8_BAR;
    }
    for (;;) {
        const bool has_next = S.next(ui + 1, nxt);
        const char* nA = has_next ? (const char*)g.A + (size_t)nxt.pm * tstep : cA; const char* nB = has_next ? (const char*)g.Bt + (size_t)nxt.pn * tstep : cB;
        if constexpr (Epi::RESID_DMA) { if (!has_next) { nA = E.resid_tile(cur); nB = nA + 256; } }
        for (int t = 0; t < nt; t += 2) {
            const bool last = (t == nt - 2);
            const char* a1 = cA + (size_t)(t + 1) * kstep;
            const char* a2 = last ? nA : cA + (size_t)(t + 2) * kstep; const char* b2 = last ? nB : cB + (size_t)(t + 2) * kstep;
            const char* a3 = a2 + kstep; const char* b3 = b2 + kstep;
            if (last && has_next) S.a_ready(nxt);
            if constexpr (SP2) {
            PG8_LDB(B0, 0, 0); PG8_LDB(B1, 0, 1); PG8_SCHED; PG8_LDA(At, 0, 0); PG8_STAGE(PG8_SA(1, 1), a1 + hstep, voffA);
            PG8_WAIT_V(8); PG8_WAIT_L(0); PG8_BAR; PG8_MMA(0, 0, At, B0); PG8_MMA(0, 1, At, B1); PG8_BAR; PG8_SCHED;
            if constexpr (Epi::RESID_DMA) { if (last && !has_next) {
                _Pragma("unroll") for (int i = 0; i < 2; ++i) { int R, C; stage_rc(tid * 16 + i * 8192, R, C); voffA[i] = voffB[i] = (unsigned)(R * 2048 + C) * 2u; }
                hstep = (size_t)HALF * 2048 * 2; } }
            PG8_LDA(At, 0, 1); PG8_STAGE(PG8_SB(0, 0), b2, voffB); PG8_STAGE(PG8_SB(0, 1), b2 + hstep, voffB); PG8_STAGE(PG8_SA(0, 0), a2, voffA);
            PG8_WAIT_V(8); PG8_WAIT_L(0); PG8_BAR; PG8_MMA(1, 0, At, B0); PG8_MMA(1, 1, At, B1); PG8_BAR; PG8_SCHED;
            PG8_LDB(B0, 1, 0); PG8_LDB(B1, 1, 1); PG8_SCHED; PG8_LDA(At, 1, 0); PG8_STAGE(PG8_SA(0, 1), a2 + hstep, voffA);
            PG8_WAIT_V(8); PG8_WAIT_L(0); PG8_BAR; PG8_MMA(0, 0, At, B0); PG8_MMA(0, 1, At, B1); PG8_BAR; PG8_SCHED;
            PG8_LDA(At, 1, 1); PG8_STAGE(PG8_SB(1, 0), b3, voffB); PG8_STAGE(PG8_SB(1, 1), b3 + hstep, voffB); PG8_STAGE(PG8_SA(1, 0), a3, voffA);
            PG8_WAIT_V(8); PG8_WAIT_L(0); PG8_BAR; PG8_MMA(1, 0, At, B0); PG8_MMA(1, 1, At, B1); PG8_BAR; PG8_SCHED;
            } else {
            PG8_LDB(B0, 0, 0); PG8_SCHED; PG8_LDA(At, 0, 0); PG8_STAGE(PG8_SA(1, 1), a1 + hstep, voffA);
            PG8_WAIT_L(8); PG8_BAR; PG8_WAIT_L(0); PG8_MMA(0, 0, At, B0); PG8_BAR; PG8_SCHED;
            PG8_LDB(B1, 0, 1); PG8_STAGE(PG8_SB(0, 0), b2, voffB);
            PG8_BAR; PG8_WAIT_L(0); PG8_MMA(0, 1, At, B1); PG8_BAR;
            PG8_LDA(At, 0, 1); PG8_STAGE(PG8_SA(0, 0), a2, voffA);
            PG8_BAR; PG8_WAIT_L(0); PG8_MMA(1, 0, At, B0); PG8_BAR; PG8_SCHED;
            PG8_STAGE(PG8_SB(0, 1), b2 + hstep, voffB);
            PG8_WAIT_V(6); PG8_BAR; PG8_MMA(1, 1, At, B1); PG8_BAR;
            PG8_LDB(B0, 1, 0); PG8_SCHED; PG8_LDA(At, 1, 0); PG8_STAGE(PG8_SA(0, 1), a2 + hstep, voffA);
            PG8_WAIT_L(8); PG8_BAR; PG8_WAIT_L(0); PG8_MMA(0, 0, At, B0); PG8_BAR; PG8_SCHED;
            PG8_LDB(B1, 1, 1); PG8_STAGE(PG8_SB(1, 0), b3, voffB);
            PG8_BAR; PG8_WAIT_L(0); PG8_MMA(0, 1, At, B1); PG8_BAR;
            PG8_LDA(At, 1, 1); PG8_STAGE(PG8_SA(1, 0), a3, voffA);
            PG8_BAR; PG8_WAIT_L(0); PG8_MMA(1, 0, At, B0); PG8_BAR; PG8_SCHED;
            PG8_STAGE(PG8_SB(1, 1), b3 + hstep, voffB);
            PG8_WAIT_V(6); PG8_BAR; PG8_MMA(1, 1, At, B1); PG8_BAR;
            }
        }
        if constexpr (ALIGN_EPI) { if (wr == 0) PG8_BAR; }
        if constexpr (FP8) asm volatile("s_nop 15\n\ts_nop 15\n\ts_nop 15" ::: "memory");
        if constexpr (!Epi::AFTER_DRAIN) { E(acc, cur, wr, wc, fr, fq); S.done(cur); }
        if (!has_next) break;
#pragma unroll
        for (int a = 0; a < 2; ++a)
#pragma unroll
            for (int b = 0; b < 2; ++b)
#pragma unroll
                for (int m = 0; m < 4; ++m)
#pragma unroll
                    for (int n = 0; n < 2; ++n) acc[a][b][m][n] = (f32x4){0.f, 0.f, 0.f, 0.f};
        cur = nxt; cA = nA; cB = nB; ++ui;
        if constexpr (ALIGN_EPI) { if (wr == 1) PG8_BAR; }
    }
    PG8_WAIT_V(0);
    if constexpr (!ALIGN_EPI) { if (wr == 0) PG8_BAR; }
    PG8_BAR;
    if constexpr (Epi::AFTER_DRAIN) { if constexpr (FP8) asm volatile("s_nop 15\n\ts_nop 15\n\ts_nop 15" ::: "memory"); E.fused(acc, cur, wr, wc, fr, fq, lds, wid, lane); S.done(cur); }
#undef PG8_SA
#undef PG8_SB
#undef PG8_STAGE
#undef PG8_LDA
#undef PG8_LDB
#undef PG8_MMA
#undef PG8_WAIT_V
#undef PG8_WAIT_L
#undef PG8_BAR
#undef PG8_SCHED
}
}

#define LAS __attribute__((address_space(3)))
using pg8::bf16_t; using pg8::bf16x8; using pg8::f32x4; using pg8::u32x4; using pg8::cvt_pk_bf16;
typedef unsigned v4u __attribute__((ext_vector_type(4)));
typedef unsigned v2u __attribute__((ext_vector_type(2)));
constexpr int MTOK = 8192, DM = 2048, FF = 5632, SEQ = 4096, PLE = 256, NGRP = 3072;
constexpr float EPS = 1e-6f;
constexpr float ACT_SCALE = 8.f, WD_SCALE = 1024.f, H_SCALE = 16.f;
constexpr size_t MiB = 1u << 20;
constexpr size_t WS_SSQ = 0, WS_WGU1 = 1 * MiB, WS_WD1 = 45 * MiB, WS_WIN = 67 * MiB, WS_WINV = 87 * MiB, WS_WOUT = 91 * MiB, WS_WGU2 = 99 * MiB, WS_WD2 = 143 * MiB,
                 WS_WGATE = 165 * MiB, WS_WPLE = 173 * MiB, WS_HB = 174 * MiB, WS_PB = 206 * MiB, WS_ACT = 210 * MiB, WS_QK = 210 * MiB, WS_VT = 242 * MiB, WS_MIX = 258 * MiB,
                 WS_G = 298 * MiB, WS_PROJ = 298 * MiB, WS_HB8 = 330 * MiB  , WS_END = 346 * MiB;
constexpr size_t QK_STRIDE = (size_t)MTOK * 1024;
constexpr int LDS_BYTES = 147456, LDS_MISC = 147392;
constexpr size_t WS_BAR = 512 * 1024;


__device__ __forceinline__ float bf_lo(unsigned w) { return __uint_as_float(w << 16); }
__device__ __forceinline__ float bf_hi(unsigned w) { return __uint_as_float(w & 0xffff0000u); }
__device__ __forceinline__ float rs_of(float ssq) { return rsqrtf(ssq * (1.f / 2048.f) + EPS); }
__device__ __forceinline__ float f8_clamp(float x) { return __builtin_amdgcn_fmed3f(x, -448.0f, 448.0f); }
__device__ __forceinline__ float sigmoid_f(float x) { return __builtin_amdgcn_rcpf(1.f + __builtin_amdgcn_exp2f(-1.4426950408889634f * x)); }
__device__ __forceinline__ float wave_sum(float v) {
#pragma unroll
    for (int o = 1; o < 64; o <<= 1) v += __shfl_xor(v, o);
    return v;
}

#define XB_LAS LAS
#define XB_TMO      128
#define XB_XCNT(j)  (256  + 64 * (j))
#define XB_XSUB(j)  (1280 + 64 * (j))
#define XB_XGEN(j)  (2304 + 64 * (j))
#define XB_TOP      3328
#define XB_TOPGEN   3392
#define XCD_BAR_WORDS 3456
#define XB_SPIN_CAP (1u << 18)

__device__ __forceinline__ unsigned xb_ld(unsigned* p)              { return __hip_atomic_load(p, __ATOMIC_RELAXED, __HIP_MEMORY_SCOPE_AGENT); }
__device__ __forceinline__ unsigned xb_add(unsigned* p, unsigned v) { return __hip_atomic_fetch_add(p, v, __ATOMIC_RELAXED, __HIP_MEMORY_SCOPE_AGENT); }
__device__ __forceinline__ unsigned xb_xcc_id() { return (unsigned)__builtin_amdgcn_s_getreg((3 << 11) | 20) & 0xFu; }
#define XB_SPIN(cond, bar) do { unsigned _sp = 0; while (cond) { __builtin_amdgcn_s_sleep(1); \
    if ((++_sp & 255u) == 0u) { if (xb_ld(&(bar)[XB_TMO])) break; if (_sp > XB_SPIN_CAP) { atomicAdd(&(bar)[XB_TMO], 1u); break; } } } } while (0)

struct XcdBarrier {
    unsigned* bar; unsigned x;
    volatile LAS unsigned* st;
};

__device__ __forceinline__ XcdBarrier xcd_barrier_post(unsigned* bar, volatile LAS unsigned* st, const bool leader_) {
    XcdBarrier b; b.bar = bar; b.x = xb_xcc_id(); b.st = st;
    if (leader_) (void)xb_add(&bar[XB_XCNT(b.x)], 1u);
    return b;
}
__device__ __forceinline__ void xcd_barrier_complete(unsigned* bar, unsigned x, unsigned& nloc, unsigned& nx) {
    const unsigned G = gridDim.x * gridDim.y * gridDim.z;
    unsigned sum, cnt, mine, sp = 0u;
    for (;;) {
        sum = 0u; cnt = 0u; mine = 0u;
#pragma unroll
        for (unsigned j = 0; j < 16; ++j) { const unsigned c = xb_ld(&bar[XB_XCNT(j)]); sum += c; cnt += (c > 0u) ? 1u : 0u; mine = (j == x) ? c : mine; }
        if (sum == G) break;
        __builtin_amdgcn_s_sleep(1);
        if ((++sp & 255u) == 0u) { if (xb_ld(&bar[XB_TMO])) break; if (sp > XB_SPIN_CAP) { atomicAdd(&bar[XB_TMO], 1u); break; } }
    }
    nloc = mine > 0u ? mine : 1u; nx = cnt > 0u ? cnt : 1u;
}

__device__ __forceinline__ void xcd_barrier(const XcdBarrier& b, const bool leader_) {
    asm volatile("s_waitcnt vmcnt(0)" ::: "memory");
    __syncthreads();
    if (leader_) {
        unsigned* bar = b.bar;
        __builtin_amdgcn_s_waitcnt(0);
        unsigned nloc = b.st[0], nx = b.st[1];
        if (nloc == 0u) { xcd_barrier_complete(bar, b.x, nloc, nx); b.st[0] = nloc; b.st[1] = nx; }
        const unsigned old = xb_add(&bar[XB_XSUB(b.x)], 1u);
        const unsigned gen = old / nloc;
        if (old + 1u == (gen + 1u) * nloc) {
            __builtin_amdgcn_fence(__ATOMIC_RELEASE, "agent");
            asm volatile("s_waitcnt vmcnt(0)" ::: "memory");
            const unsigned og = xb_add(&bar[XB_TOP], 1u);
            const unsigned tg = og / nx;
            if (og + 1u == (tg + 1u) * nx) xb_add(&bar[XB_TOPGEN], 1u);
            else XB_SPIN(xb_ld(&bar[XB_TOPGEN]) == tg, bar);
            __builtin_amdgcn_fence(__ATOMIC_ACQUIRE, "agent");
            xb_add(&bar[XB_XGEN(b.x)], 1u);
            asm volatile("s_waitcnt vmcnt(0)" ::: "memory");
        } else {
            XB_SPIN(xb_ld(&bar[XB_XGEN(b.x)]) == gen, bar);
            __builtin_amdgcn_fence(__ATOMIC_ACQUIRE, "agent");
            asm volatile("s_waitcnt vmcnt(0)" ::: "memory");
        }
    }
    __syncthreads();
}

template <bool F8> struct EpiSwiGLU {
    static constexpr bool PERM = true, AFTER_DRAIN = false, RESID_DMA = false;
    unsigned char* O; const float* ssq; float mul;
    __device__ __forceinline__ void operator()(const f32x4 (&acc)[2][2][4][2], const pg8::Unit& u, int wr, int wc, int fr, int fq) const {
        const int row0 = u.pm * 256 + wr * 64 + fr, col0 = u.pn * 128 + wc * 32 + 8 * fq;
        float sq[2][4];
#pragma unroll
        for (int ai = 0; ai < 2; ++ai)
#pragma unroll
            for (int m = 0; m < 4; ++m) sq[ai][m] = ssq[row0 + ai * 128 + m * 16];
#pragma unroll
        for (int ai = 0; ai < 2; ++ai)
#pragma unroll
            for (int m = 0; m < 4; ++m) {
                const int row = row0 + ai * 128 + m * 16; const float r = rs_of(sq[ai][m]) * mul, rn = r * -1.4426950408889634f, ru = r * (F8 ? ACT_SCALE : 1.f);
                float o[8];
#pragma unroll
                for (int n = 0; n < 2; ++n) {
                    const f32x4 ag = acc[ai][0][m][n], Gv = ag * r, Tv = ag * rn, Uv = acc[ai][1][m][n] * ru;
                    f32x4 Ev; Ev[0] = __builtin_amdgcn_exp2f(Tv[0]); Ev[1] = __builtin_amdgcn_exp2f(Tv[1]); Ev[2] = __builtin_amdgcn_exp2f(Tv[2]); Ev[3] = __builtin_amdgcn_exp2f(Tv[3]);
                    Ev = Ev + 1.0f;
                    f32x4 Sv; Sv[0] = __builtin_amdgcn_rcpf(Ev[0]); Sv[1] = __builtin_amdgcn_rcpf(Ev[1]); Sv[2] = __builtin_amdgcn_rcpf(Ev[2]); Sv[3] = __builtin_amdgcn_rcpf(Ev[3]);
                    const f32x4 Ov = (Gv * Sv) * Uv;
                    o[4 * n + 0] = Ov[0]; o[4 * n + 1] = Ov[1]; o[4 * n + 2] = Ov[2]; o[4 * n + 3] = Ov[3];
                }
                if constexpr (F8) {
                int w0 = __builtin_amdgcn_cvt_pk_fp8_f32(f8_clamp(o[0]), f8_clamp(o[1]), 0, false); w0 = __builtin_amdgcn_cvt_pk_fp8_f32(f8_clamp(o[2]), f8_clamp(o[3]), w0, true);
                int w1 = __builtin_amdgcn_cvt_pk_fp8_f32(f8_clamp(o[4]), f8_clamp(o[5]), 0, false); w1 = __builtin_amdgcn_cvt_pk_fp8_f32(f8_clamp(o[6]), f8_clamp(o[7]), w1, true);
                v2u w; w.x = (unsigned)w0; w.y = (unsigned)w1;
                *(v2u*)(O + (size_t)row * FF + col0) = w;
                } else {
                u32x4 w; w.x = cvt_pk_bf16(o[0], o[1]); w.y = cvt_pk_bf16(o[2], o[3]); w.z = cvt_pk_bf16(o[4], o[5]); w.w = cvt_pk_bf16(o[6], o[7]);
                *(u32x4*)((bf16_t*)O + (size_t)row * FF + col0) = w; }
            }
    }
};
template <bool RES16, bool OUT8> struct EpiResid {
    static constexpr bool PERM = true, AFTER_DRAIN = false, RESID_DMA = false;
    const float* R; bf16_t* HB; unsigned char* HB8; float* ssq; float alpha;
    __device__ __forceinline__ void operator()(const f32x4 (&acc)[2][2][4][2], const pg8::Unit& u, int wr, int wc, int fr, int fq) const {
        const int row0 = u.pm * 256 + wr * 64 + fr, col0 = u.pn * 256 + wc * 32 + 8 * fq;
#pragma unroll
        for (int ai = 0; ai < 2; ++ai)
#pragma unroll
            for (int m = 0; m < 4; ++m) {
                const int row = row0 + ai * 128 + m * 16; float s = 0.f;
#pragma unroll
                for (int bj = 0; bj < 2; ++bj) {
                    const size_t off = (size_t)row * DM + col0 + bj * 128;
                    f32x4 r0, r1;
                    if constexpr (RES16) { const v4u q = *(const v4u*)(HB + off); r0 = (f32x4){bf_lo(q.x), bf_hi(q.x), bf_lo(q.y), bf_hi(q.y)}; r1 = (f32x4){bf_lo(q.z), bf_hi(q.z), bf_lo(q.w), bf_hi(q.w)}; }
                    else { r0 = __builtin_nontemporal_load((const f32x4*)(R + off)); r1 = __builtin_nontemporal_load((const f32x4*)(R + off + 4)); }
                    const f32x4 v0 = r0 + acc[ai][bj][m][0] * alpha, v1 = r1 + acc[ai][bj][m][1] * alpha;
                    if constexpr (OUT8) {
                        int w0 = __builtin_amdgcn_cvt_pk_fp8_f32(f8_clamp(v0[0] * H_SCALE), f8_clamp(v0[1] * H_SCALE), 0, false); w0 = __builtin_amdgcn_cvt_pk_fp8_f32(f8_clamp(v0[2] * H_SCALE), f8_clamp(v0[3] * H_SCALE), w0, true);
                        int w1 = __builtin_amdgcn_cvt_pk_fp8_f32(f8_clamp(v1[0] * H_SCALE), f8_clamp(v1[1] * H_SCALE), 0, false); w1 = __builtin_amdgcn_cvt_pk_fp8_f32(f8_clamp(v1[2] * H_SCALE), f8_clamp(v1[3] * H_SCALE), w1, true);
                        v2u w; w.x = (unsigned)w0; w.y = (unsigned)w1; *(v2u*)(HB8 + off) = w;
                    }
                    { u32x4 w; w.x = cvt_pk_bf16(v0[0], v0[1]); w.y = cvt_pk_bf16(v0[2], v0[3]); w.z = cvt_pk_bf16(v1[0], v1[1]); w.w = cvt_pk_bf16(v1[2], v1[3]);
                      *(u32x4*)(HB + off) = w; }
                    s += (v0[0] * v0[0] + v0[1] * v0[1]) + (v0[2] * v0[2] + v0[3] * v0[3]) + (v1[0] * v1[0] + v1[1] * v1[1]) + (v1[2] * v1[2] + v1[3] * v1[3]);
                }
                s += __shfl_xor(s, 16); s += __shfl_xor(s, 32);
                if (fq == 0) unsafeAtomicAdd(ssq + row, s);
            }
    }
};
template <bool OUT8> struct EpiResidL {
    static constexpr bool PERM = true, AFTER_DRAIN = true, RESID_DMA = true;
    bf16_t* HB; unsigned char* HB8; float* ssq; float alpha;
    __device__ __forceinline__ const char* resid_tile(const pg8::Unit& u) const { return (const char*)(HB + (size_t)(u.pm * 256) * DM + u.pn * 256); }
    __device__ __forceinline__ void fused(f32x4 (&acc)[2][2][4][2], const pg8::Unit& u, int wr, int wc, int fr, int fq, LAS unsigned char* img, int wid, int lane) const {
        const int row0 = u.pm * 256 + wr * 64 + fr, col0 = u.pn * 256 + wc * 32 + 8 * fq;
        bf16_t* gtile = HB + (size_t)(u.pm * 256) * DM + u.pn * 256;
        v4u qm[4];
        if (wc >= 2) {
#pragma unroll
            for (int m = 0; m < 4; ++m) qm[m] = *(const v4u*)(HB + (size_t)(row0 + 128 + m * 16) * DM + col0);
        }
#pragma unroll
        for (int ai = 0; ai < 2; ++ai)
#pragma unroll
            for (int m = 0; m < 4; ++m) {
                const int row = row0 + ai * 128 + m * 16, rl = wr * 64 + m * 16 + fr; float s = 0.f;
#pragma unroll
                for (int bj = 0; bj < 2; ++bj) {
                    const size_t off = (size_t)row * DM + col0 + bj * 128;
                    LAS v4u* slot = (LAS v4u*)(img + ((bj * 2 + (wc >> 1)) * 2 + ai) * 16384 + pg8::lds_byte(rl, (wc & 1) * 32 + fq * 8));
                    v4u q = *slot;
                    if (ai == 1 && bj == 0) { if (wc >= 2) q = qm[m]; }
                    const f32x4 r0 = (f32x4){bf_lo(q.x), bf_hi(q.x), bf_lo(q.y), bf_hi(q.y)}, r1 = (f32x4){bf_lo(q.z), bf_hi(q.z), bf_lo(q.w), bf_hi(q.w)};
                    const f32x4 v0 = r0 + acc[ai][bj][m][0] * alpha, v1 = r1 + acc[ai][bj][m][1] * alpha;
                    if constexpr (OUT8) {
                        int w0 = __builtin_amdgcn_cvt_pk_fp8_f32(f8_clamp(v0[0] * H_SCALE), f8_clamp(v0[1] * H_SCALE), 0, false); w0 = __builtin_amdgcn_cvt_pk_fp8_f32(f8_clamp(v0[2] * H_SCALE), f8_clamp(v0[3] * H_SCALE), w0, true);
                        int w1 = __builtin_amdgcn_cvt_pk_fp8_f32(f8_clamp(v1[0] * H_SCALE), f8_clamp(v1[1] * H_SCALE), 0, false); w1 = __builtin_amdgcn_cvt_pk_fp8_f32(f8_clamp(v1[2] * H_SCALE), f8_clamp(v1[3] * H_SCALE), w1, true);
                        v2u w; w.x = (unsigned)w0; w.y = (unsigned)w1; *(v2u*)(HB8 + off) = w;
                    }
                    { v4u w; w.x = cvt_pk_bf16(v0[0], v0[1]); w.y = cvt_pk_bf16(v0[2], v0[3]); w.z = cvt_pk_bf16(v1[0], v1[1]); w.w = cvt_pk_bf16(v1[2], v1[3]); *slot = w; }
                    s += (v0[0] * v0[0] + v0[1] * v0[1]) + (v0[2] * v0[2] + v0[3] * v0[3]) + (v1[0] * v1[0] + v1[1] * v1[1]) + (v1[2] * v1[2] + v1[3] * v1[3]);
                }
                s += __shfl_xor(s, 16); s += __shfl_xor(s, 32);
                if (fq == 0) unsafeAtomicAdd(ssq + row, s);
            }
        asm volatile("s_waitcnt lgkmcnt(0)" ::: "memory"); __builtin_amdgcn_s_barrier(); asm volatile("" ::: "memory");
        const int rr = wid * 32 + (lane >> 5), cc = lane & 31;
#pragma unroll
        for (int j = 0; j < 16; ++j) { const int r = rr + 2 * j;
            const v4u w = *(const LAS v4u*)(img + ((cc >> 3) * 2 + (r >> 7)) * 16384 + pg8::lds_byte(r & 127, (cc & 7) * 8));
            *(v4u*)(gtile + (size_t)r * DM + cc * 8) = w; }
        asm volatile("s_waitcnt lgkmcnt(0)" ::: "memory"); __builtin_amdgcn_s_barrier(); asm volatile("" ::: "memory");
    }
};
struct EpiWin {
    static constexpr bool PERM = true, AFTER_DRAIN = false, RESID_DMA = false;
    bf16_t* QK; bf16_t* G; const float* ssq;
    __device__ __forceinline__ void operator()(const f32x4 (&acc)[2][2][4][2], const pg8::Unit& u, int wr, int wc, int fr, int fq) const {
        const int row0 = u.pm * 256 + wr * 64 + fr, cin = wc * 32 + 8 * fq;
        float sq[2][4];
#pragma unroll
        for (int ai = 0; ai < 2; ++ai)
#pragma unroll
            for (int m = 0; m < 4; ++m) sq[ai][m] = ssq[row0 + ai * 128 + m * 16];
#pragma unroll
        for (int ai = 0; ai < 2; ++ai)
#pragma unroll
            for (int m = 0; m < 4; ++m) {
                const int row = row0 + ai * 128 + m * 16; const float r = rs_of(sq[ai][m]);
#pragma unroll
                for (int bj = 0; bj < 2; ++bj) {
                    const f32x4 v0 = acc[ai][bj][m][0] * r, v1 = acc[ai][bj][m][1] * r;
                    u32x4 w; w.x = cvt_pk_bf16(v0[0], v0[1]); w.y = cvt_pk_bf16(v0[2], v0[3]); w.z = cvt_pk_bf16(v1[0], v1[1]); w.w = cvt_pk_bf16(v1[2], v1[3]);
                    bf16_t* dst;
                    if (u.pn < 8) { const int which = u.pn >> 2, head = (u.pn & 3) * 2 + bj, b = row >> 12, t = row & 4095;
                        dst = QK + (size_t)which * QK_STRIDE + ((size_t)((b * 8 + head) * 4096 + t)) * 128 + cin; }
                    else dst = G + (size_t)row * NGRP + (u.pn - 8) * 256 + bj * 128 + cin;
                    *(u32x4*)dst = w;
                }
            }
    }
};
struct EpiCol {
    static constexpr bool PERM = true, AFTER_DRAIN = false, RESID_DMA = false;
    bf16_t* O; int ldc; const float* ssq;
    __device__ __forceinline__ void operator()(const f32x4 (&acc)[2][2][4][2], const pg8::Unit& u, int wr, int wc, int fr, int fq) const {
        const int row0 = u.pm * 256 + wr * 64 + fr, col0 = u.pn * 256 + wc * 32 + 8 * fq;
        f32x4 cs[2][2];
#pragma unroll
        for (int bj = 0; bj < 2; ++bj)
#pragma unroll
            for (int n = 0; n < 2; ++n) {
                if (ssq) { const f32x4 q = *(const f32x4*)(ssq + col0 + bj * 128 + 4 * n); cs[bj][n] = (f32x4){rs_of(q[0]), rs_of(q[1]), rs_of(q[2]), rs_of(q[3])}; }
                else cs[bj][n] = (f32x4){1.f, 1.f, 1.f, 1.f};
            }
#pragma unroll
        for (int ai = 0; ai < 2; ++ai)
#pragma unroll
            for (int m = 0; m < 4; ++m) {
                const int row = row0 + ai * 128 + m * 16;
#pragma unroll
                for (int bj = 0; bj < 2; ++bj) {
                    const f32x4 v0 = acc[ai][bj][m][0] * cs[bj][0], v1 = acc[ai][bj][m][1] * cs[bj][1];
                    u32x4 w; w.x = cvt_pk_bf16(v0[0], v0[1]); w.y = cvt_pk_bf16(v0[2], v0[3]); w.z = cvt_pk_bf16(v1[0], v1[1]); w.w = cvt_pk_bf16(v1[2], v1[3]);
                    *(u32x4*)(O + (size_t)row * ldc + col0 + bj * 128) = w;
                }
            }
    }
};
struct EpiPleNorm {
    static constexpr bool PERM = true, AFTER_DRAIN = false, RESID_DMA = false;
    const bf16_t* H; float* OUT; const bf16_t* PROJ; const float* ssq3; float* ssq4; unsigned* cnt; const float* gfin; float mul;
    __device__ __forceinline__ void operator()(f32x4 (&acc)[2][2][4][2], const pg8::Unit& u, int wr, int wc, int fr, int fq) const {
        const int row0 = u.pm * 256 + wr * 64 + fr, col0 = u.pn * 256 + wc * 32 + 8 * fq;
#pragma unroll
        for (int ai = 0; ai < 2; ++ai)
#pragma unroll
            for (int m = 0; m < 4; ++m) {
                const int row = row0 + ai * 128 + m * 16; const float r = rs_of(ssq3[row]) * mul; float s = 0.f;
#pragma unroll
                for (int bj = 0; bj < 2; ++bj) {
                    const size_t off = (size_t)row * DM + col0 + bj * 128;
                    const v4u hq = *(const v4u*)(H + off);
                    const f32x4 h0 = (f32x4){bf_lo(hq.x), bf_hi(hq.x), bf_lo(hq.y), bf_hi(hq.y)}, h1 = (f32x4){bf_lo(hq.z), bf_hi(hq.z), bf_lo(hq.w), bf_hi(hq.w)};
                    const v4u pr = __builtin_nontemporal_load((const v4u*)(PROJ + off));
                    const f32x4 p0 = (f32x4){bf_lo(pr.x), bf_hi(pr.x), bf_lo(pr.y), bf_hi(pr.y)}, p1 = (f32x4){bf_lo(pr.z), bf_hi(pr.z), bf_lo(pr.w), bf_hi(pr.w)};
                    const f32x4 a0 = acc[ai][bj][m][0] * r, a1 = acc[ai][bj][m][1] * r;
                    f32x4 v0, v1;
#pragma unroll
                    for (int e = 0; e < 4; ++e) { v0[e] = h0[e] + sigmoid_f(a0[e]) * p0[e]; v1[e] = h1[e] + sigmoid_f(a1[e]) * p1[e]; }
                    acc[ai][bj][m][0] = v0; acc[ai][bj][m][1] = v1;
                    s += (v0[0] * v0[0] + v0[1] * v0[1]) + (v0[2] * v0[2] + v0[3] * v0[3]) + (v1[0] * v1[0] + v1[1] * v1[1]) + (v1[2] * v1[2] + v1[3] * v1[3]);
                }
                s += __shfl_xor(s, 16); s += __shfl_xor(s, 32);
                if (fq == 0) unsafeAtomicAdd(ssq4 + row, s);
            }
        asm volatile("s_waitcnt vmcnt(0)" ::: "memory");
        unsigned* cw = cnt + 64 * u.pm;
        if (fr == 0 && fq == 0) __hip_atomic_fetch_add(cw, 1u, __ATOMIC_RELAXED, __HIP_MEMORY_SCOPE_AGENT);
        f32x4 gf[2][2];
#pragma unroll
        for (int bj = 0; bj < 2; ++bj) { gf[bj][0] = *(const f32x4*)(gfin + col0 + bj * 128); gf[bj][1] = *(const f32x4*)(gfin + col0 + bj * 128 + 4); }
        { unsigned sp = 0; while ((unsigned)__builtin_amdgcn_readfirstlane((int)__hip_atomic_load(cw, __ATOMIC_RELAXED, __HIP_MEMORY_SCOPE_AGENT)) < 64u) { __builtin_amdgcn_s_sleep(2); if (++sp > (1u << 22)) break; } }
        asm volatile("" ::: "memory");
        float sq4[2][4];
#pragma unroll
        for (int ai = 0; ai < 2; ++ai)
#pragma unroll
            for (int m = 0; m < 4; ++m) sq4[ai][m] = __hip_atomic_load(ssq4 + row0 + ai * 128 + m * 16, __ATOMIC_RELAXED, __HIP_MEMORY_SCOPE_AGENT);
#pragma unroll
        for (int ai = 0; ai < 2; ++ai)
#pragma unroll
            for (int m = 0; m < 4; ++m) {
                const int row = row0 + ai * 128 + m * 16;
                const float r4 = rs_of(sq4[ai][m]);
#pragma unroll
                for (int bj = 0; bj < 2; ++bj) {
                    const size_t off = (size_t)row * DM + col0 + bj * 128;
                    *(f32x4*)(OUT + off) = acc[ai][bj][m][0] * r4 * gf[bj][0]; *(f32x4*)(OUT + off + 4) = acc[ai][bj][m][1] * r4 * gf[bj][1];
                }
            }
    }
};

struct Args { const float* in[22]; float* out; unsigned char* ws; };
struct TrDesc { const float* src; const float* gk; bf16_t* dst; int N, K, f8; };
struct TwDesc { const float* src; const float* gk; unsigned char* dst; int N, K, f8, gu; };
constexpr int TW_GU = 16 * 22, TW_WD = 44 * 8, TW_IN = 16 * 24, TW_SQ = 16 * 8, TW_PL = 2 * 8;
constexpr int TW_END_A = 4 * TW_GU, TW_END_B = TW_END_A + TW_SQ + TW_PL + TW_WD + TW_IN, TW_NITEMS = TW_END_B + TW_WD + TW_SQ;
__device__ __forceinline__ void tw_decode(const Args& a, unsigned char* ws, int it, TwDesc& d) {
    int r = it; const float* W; const float* gk = nullptr; size_t wt; int N, K, kb, nb, drow, f8 = 0, gu = 0;
    if (r < TW_END_A) {
        const int which = r / TW_GU; r -= which * TW_GU;
        kb = r / 22; nb = r % 22; N = FF; K = DM; gu = 1;
        W = a.in[which == 0 ? 3 : which == 1 ? 4 : which == 2 ? 15 : 16]; gk = a.in[which < 2 ? 2 : 14];
        wt = which < 2 ? WS_WGU1 : WS_WGU2; drow = nb * 512 + (which & 1) * 128; f8 = which >> 1;
    } else if (r < TW_END_B) {
        r -= TW_END_A;
        if (r < TW_SQ) { kb = r / 8; nb = r % 8; N = DM; K = DM; W = a.in[13]; wt = WS_WOUT; drow = nb * 256; }
        else if ((r -= TW_SQ) < TW_PL) { kb = r / 8; nb = r % 8; N = DM; K = PLE; W = a.in[20]; wt = WS_WPLE; drow = nb * 256; }
        else if ((r -= TW_PL) < TW_WD) { kb = r / 8; nb = r % 8; N = DM; K = FF; W = a.in[5]; wt = WS_WD1; drow = nb * 256; }
        else { r -= TW_WD; kb = r / 24; nb = r % 24; N = 6144; K = DM; W = a.in[7]; gk = a.in[6]; const int n0 = nb * 256;
            wt = WS_WIN; drow = n0;
            if (n0 >= 3072) drow = n0 - 1024; else if (n0 >= 2048) { wt = WS_WINV; drow = n0 - 2048; } }
    } else {
        r -= TW_END_B;
        if (r < TW_WD) { kb = r / 8; nb = r % 8; N = DM; K = FF; W = a.in[17]; wt = WS_WD2; drow = nb * 256; f8 = 1; }
        else { r -= TW_WD; kb = r / 8; nb = r % 8; N = DM; K = DM; W = a.in[19]; gk = a.in[18]; wt = WS_WGATE; drow = nb * 256; }
    }
    const int k0 = kb * 128, n0 = nb * 256;
    d.src = W + (size_t)k0 * N + n0; d.gk = gk ? gk + k0 : nullptr; d.N = N; d.K = K; d.f8 = f8; d.gu = gu;
    d.dst = ws + wt + ((size_t)drow * K + k0) * (f8 ? 1 : 2);
}
__device__ __forceinline__ void tw_range(const Args& a, unsigned char* ws, LAS unsigned char* lds, int wave, int lane, int lo, int hi, int w, int nw) {
    LAS float* img = (LAS float*)lds;
    f32x4 v[16]; TwDesc cur; int it = lo + w;
    if (it < hi) { tw_decode(a, ws, it, cur);
#pragma unroll
        for (int j = 0; j < 16; ++j) v[j] = __builtin_nontemporal_load((const f32x4*)(cur.src + (size_t)(wave * 16 + j) * cur.N + lane * 4)); }
    const int tid = wave * 64 + lane;
    while (it < hi) {
        __syncthreads();
#pragma unroll
        for (int j = 0; j < 16; ++j) { const int k = wave * 16 + j; const float g = cur.gk ? cur.gk[k] : 1.0f;
            *(LAS f32x4*)(img + k * 256 + ((lane * 4) ^ (((k >> 3) & 15) << 2))) = v[j] * g; }
        const int itn = it + nw; TwDesc nxt = cur;
        if (itn < hi) { tw_decode(a, ws, itn, nxt);
#pragma unroll
            for (int j = 0; j < 16; ++j) v[j] = __builtin_nontemporal_load((const f32x4*)(nxt.src + (size_t)(wave * 16 + j) * nxt.N + lane * 4)); }
        __syncthreads();
#pragma unroll
        for (int q8 = 0; q8 < 8; ++q8) { const int q = tid + 512 * q8, c = q & 15, n = q >> 4;
            const LAS float* sp = img + (8 * c) * 256 + (n ^ (c << 2));
            const float s0 = sp[0], s1 = sp[256], s2 = sp[512], s3 = sp[768], s4 = sp[1024], s5 = sp[1280], s6 = sp[1536], s7 = sp[1792];
            const size_t row = (size_t)(n + (cur.gu ? (n >> 7) * 128 : 0));
            if (cur.f8) {
                int w0 = __builtin_amdgcn_cvt_pk_fp8_f32(f8_clamp(s0 * WD_SCALE), f8_clamp(s1 * WD_SCALE), 0, false); w0 = __builtin_amdgcn_cvt_pk_fp8_f32(f8_clamp(s2 * WD_SCALE), f8_clamp(s3 * WD_SCALE), w0, true);
                int w1 = __builtin_amdgcn_cvt_pk_fp8_f32(f8_clamp(s4 * WD_SCALE), f8_clamp(s5 * WD_SCALE), 0, false); w1 = __builtin_amdgcn_cvt_pk_fp8_f32(f8_clamp(s6 * WD_SCALE), f8_clamp(s7 * WD_SCALE), w1, true);
                v2u o; o.x = (unsigned)w0; o.y = (unsigned)w1;
                *(v2u*)(cur.dst + row * cur.K + 8 * c) = o;
            } else {
                v4u o; o.x = cvt_pk_bf16(s0, s1); o.y = cvt_pk_bf16(s2, s3); o.z = cvt_pk_bf16(s4, s5); o.w = cvt_pk_bf16(s6, s7);
                *(v4u*)(cur.dst + (row * cur.K + 8 * c) * 2) = o; } }
        cur = nxt; it = itn;
    }
    __syncthreads();
}
__device__ __forceinline__ void tr_idle(const Args& a, unsigned char* ws, LAS unsigned char* lds, int wave, int bid, int G, int nwg, int lo, int hi) {
    const int rem = nwg % G, first = rem, nblk = G - rem;
    if (bid >= first) tw_range(a, ws, lds, wave, pg8::lane_id_v(), lo, hi, bid - first, nblk);
}
__device__ __forceinline__ void conv_ldx(const bf16_t* Grow, int ch, bool valid, float (&x)[8]) {
    if (valid) { const v4u a = __builtin_nontemporal_load((const v4u*)(Grow + 1024 + ch)), b = __builtin_nontemporal_load((const v4u*)(Grow + 2048 + ch));
        x[0] = bf_lo(a.x) * bf_lo(b.x); x[1] = bf_hi(a.x) * bf_hi(b.x); x[2] = bf_lo(a.y) * bf_lo(b.y); x[3] = bf_hi(a.y) * bf_hi(b.y);
        x[4] = bf_lo(a.z) * bf_lo(b.z); x[5] = bf_hi(a.z) * bf_hi(b.z); x[6] = bf_lo(a.w) * bf_lo(b.w); x[7] = bf_hi(a.w) * bf_hi(b.w); }
    else {
#pragma unroll
        for (int e = 0; e < 8; ++e) x[e] = 0.f; }
}

__global__ void __launch_bounds__(512, 2) mk_fwd(Args a) {
    extern __shared__ __attribute__((aligned(16))) unsigned char lds_raw[];
    LAS unsigned char* lds = (LAS unsigned char*)lds_raw;
    cg::grid_group grid = cg::this_grid();
    const int wave = __builtin_amdgcn_readfirstlane((int)threadIdx.x >> 6);
#define LANE_TID() const int lane = pg8::lane_id_v(), tid = wave * 64 + lane; (void)tid
    const int G = gridDim.x, bid = blockIdx.x, gw = bid * 8 + wave, NGW = G * 8;
    unsigned char* ws = a.ws;
    const float* x = a.in[0]; float* out = a.out;
    float* ssq0 = (float*)(ws + WS_SSQ); float* ssq1 = ssq0 + MTOK; float* ssq2 = ssq1 + MTOK; float* ssq3 = ssq2 + MTOK; float* ssq4 = ssq3 + MTOK;
    bf16_t* WGU1 = (bf16_t*)(ws + WS_WGU1); bf16_t* WD1 = (bf16_t*)(ws + WS_WD1); bf16_t* WIN = (bf16_t*)(ws + WS_WIN); bf16_t* WINV = (bf16_t*)(ws + WS_WINV);
    bf16_t* WOUT = (bf16_t*)(ws + WS_WOUT); bf16_t* WGU2 = (bf16_t*)(ws + WS_WGU2); bf16_t* WD2 = (bf16_t*)(ws + WS_WD2); bf16_t* WGATE = (bf16_t*)(ws + WS_WGATE);
    bf16_t* WPLE = (bf16_t*)(ws + WS_WPLE); bf16_t* HB = (bf16_t*)(ws + WS_HB); bf16_t* PB = (bf16_t*)(ws + WS_PB); unsigned char* ACT = ws + WS_ACT;
    bf16_t* QK = (bf16_t*)(ws + WS_QK); bf16_t* VT = (bf16_t*)(ws + WS_VT); bf16_t* MIX = (bf16_t*)(ws + WS_MIX); bf16_t* GB = (bf16_t*)(ws + WS_G); bf16_t* PROJ = (bf16_t*)(ws + WS_PROJ);

    unsigned* barw = (unsigned*)(ws + WS_BAR); unsigned* pcnt = (unsigned*)(ssq4 + MTOK);
    volatile LAS unsigned* MISC = (volatile LAS unsigned*)(lds + LDS_MISC);
    { LANE_TID(); if (tid < 2) MISC[tid] = 0u; }
    const XcdBarrier bar = xcd_barrier_post(barw, MISC, wave == 0 && pg8::lane_id_v() == 0);
    if (gridDim.y == 0x7fffu) grid.sync();
    {
        LANE_TID();
        for (int i = bid * 512 + tid; i < 4 * MTOK + 32 * 64; i += G * 512) ssq1[i] = 0.f;
        for (int row = gw; row < MTOK; row += NGW) {
            const f32x4* xr = (const f32x4*)(x + (size_t)row * DM) + lane;
            f32x4 v[8]; float s = 0.f;
#pragma unroll
            for (int j = 0; j < 8; ++j) { v[j] = __builtin_nontemporal_load(xr + 64 * j); s += (v[j][0] * v[j][0] + v[j][1] * v[j][1]) + (v[j][2] * v[j][2] + v[j][3] * v[j][3]); }
            s = wave_sum(s);
            if (lane == 0) ssq0[row] = s;
            v2u* o = (v2u*)(HB + (size_t)row * DM) + lane;
#pragma unroll
            for (int j = 0; j < 8; ++j) { v2u w; w.x = cvt_pk_bf16(v[j][0], v[j][1]); w.y = cvt_pk_bf16(v[j][2], v[j][3]); o[64 * j] = w; }
            const f32x4 pv = __builtin_nontemporal_load((const f32x4*)(a.in[1] + (size_t)row * PLE) + lane);
            v2u pw; pw.x = cvt_pk_bf16(pv[0], pv[1]); pw.y = cvt_pk_bf16(pv[2], pv[3]);
            ((v2u*)(PB + (size_t)row * PLE))[lane] = pw;
        }
        tw_range(a, ws, lds, wave, lane, 0, 2 * TW_GU, bid, G);
    }
    xcd_barrier(bar, wave == 0 && pg8::lane_id_v() == 0);
    { pg8::Gemm g{HB, WGU1, MTOK, 2 * FF, DM}; pg8::StaticOrder S; S.init(MTOK, 2 * FF, G, bid); EpiSwiGLU<false> E{ACT, ssq0, 1.0f};
      pg8::gemm_phase<EpiSwiGLU<false>, pg8::StaticOrder, true, true>(lds, g, S, E, wave); }
    tr_idle(a, ws, lds, wave, bid, G, (MTOK / 256) * (2 * FF / 256), TW_END_A, TW_END_B);
    xcd_barrier(bar, wave == 0 && pg8::lane_id_v() == 0);
    { pg8::Gemm g{(const bf16_t*)ACT, WD1, MTOK, DM, FF}; pg8::StaticOrder S; S.init(MTOK, DM, G, bid); EpiResidL<false> E{HB, nullptr, ssq1, 0.5f};
      pg8::gemm_phase<EpiResidL<false>, pg8::StaticOrder, true, true, false>(lds, g, S, E, wave); }
    xcd_barrier(bar, wave == 0 && pg8::lane_id_v() == 0);
    { pg8::Gemm g{HB, WIN, MTOK, 5120, DM}; pg8::StaticOrder S; S.init(MTOK, 5120, G, bid); EpiWin E{QK, GB, ssq1};
      pg8::gemm_phase<EpiWin, pg8::StaticOrder, true, true>(lds, g, S, E, wave); }
    { pg8::Gemm g{WINV, HB, 1024, MTOK, DM}; pg8::StaticOrder S; S.init(1024, MTOK, G, (bid + G / 2) % G); EpiCol E{VT, MTOK, ssq1};
      pg8::gemm_phase<EpiCol, pg8::StaticOrder, true, true>(lds, g, S, E, wave); }
    xcd_barrier(bar, wave == 0 && pg8::lane_id_v() == 0);
    {
        LANE_TID();
        tw_range(a, ws, lds, wave, lane, 2 * TW_GU, 4 * TW_GU, bid, G);
        LAS float* rpb_l = (LAS float*)lds;
        LAS unsigned char* ring = lds + 15360;
        constexpr int SLOT = 18432;
        for (int i = tid; i < 8 * 15 * 31; i += 512) rpb_l[i] = a.in[8][i];
        __syncthreads();
        const bf16_t* QH = QK; const bf16_t* KH = QK + QK_STRIDE;
        const float* g_attn = a.in[11];
        const int j16 = lane & 15, kq = lane >> 4;
        const int kdst = (tid >> 4) * 272 + (tid & 15) * 16, vdst = (tid >> 3) * 144 + (tid & 7) * 16;
        for (int Wu = bid; Wu < 512; Wu += G) {
            const int xcd = Wu & 7, rp = (Wu >> 3) & 31, iter = Wu >> 8, bh = 2 * xcd + iter;
            const int r = 2 * rp + (wave >> 2), cb = wave & 3, b = bh >> 3, h = bh & 7;
            const int rsU = min(max(2 * rp - 4, 0), 56), rs = min(max(r - 4, 0), 56), dsh = rs - rsU, nU = min(max(2 * rp - 3, 0), 56) + 8 - rsU;
            const int kc0 = (cb == 0) ? 0 : (cb == 1) ? 8 : (cb == 2) ? 24 : 32;
            const size_t bhbase = (size_t)(b * 8 + h) * 4096;
            v4u kr[9][2];
            const unsigned char* Kg = (const unsigned char*)(KH + (bhbase + rsU * 64) * 128) + tid * 16;
#pragma unroll
            for (int j = 0; j < 9; ++j) if (j < nU) { kr[j][0] = *(const v4u*)(Kg + j * 16384); kr[j][1] = *(const v4u*)(Kg + j * 16384 + 8192); }
            const bf16_t* Qp = QH + (bhbase + r * 64 + cb * 16 + j16) * 128 + 8 * kq;
            bf16x8 qf[4];
#pragma unroll
            for (int ks = 0; ks < 4; ++ks) qf[ks] = *(const bf16x8*)(Qp + 32 * ks);
            *(LAS v4u*)(ring + kdst) = kr[0][0]; *(LAS v4u*)(ring + kdst + 32 * 272) = kr[0][1];
            asm volatile("s_waitcnt lgkmcnt(0)" ::: "memory"); __builtin_amdgcn_s_barrier(); asm volatile("" ::: "memory");
            const int koff = (kc0 + 8 * (j16 >> 2) + (j16 & 3)) * 272 + kq * 16;
            f32x4 sc[8][2];
#define ATT_S(I, BUF) do { bf16x8 k0_[4], k1_[4]; _Pragma("unroll") for (int ks = 0; ks < 4; ++ks) { k0_[ks] = *(const LAS bf16x8*)((BUF) + koff + ks * 64); k1_[ks] = *(const LAS bf16x8*)((BUF) + koff + 4 * 272 + ks * 64); } \
                f32x4 s0_ = (f32x4){0.f, 0.f, 0.f, 0.f}, s1_ = (f32x4){0.f, 0.f, 0.f, 0.f}; \
                _Pragma("unroll") for (int ks = 0; ks < 4; ++ks) { s0_ = __builtin_amdgcn_mfma_f32_16x16x32_bf16(k0_[ks], qf[ks], s0_, 0, 0, 0); s1_ = __builtin_amdgcn_mfma_f32_16x16x32_bf16(k1_[ks], qf[ks], s1_, 0, 0, 0); } \
                sc[I][0] = s0_; sc[I][1] = s1_; } while (0)
#pragma unroll
            for (int t = 0; t < 9; ++t) if (t < nU) {
                const LAS unsigned char* buf = ring + (t & 1) * SLOT;
                if (dsh == 0) { if (t < 8) ATT_S(t < 8 ? t : 0, buf); } else { if (t >= 1) ATT_S(t >= 1 ? t - 1 : 0, buf); }
                if (t + 1 < nU) { LAS unsigned char* nb = ring + ((t + 1) & 1) * SLOT; *(LAS v4u*)(nb + kdst) = kr[t + 1 < 9 ? t + 1 : 8][0]; *(LAS v4u*)(nb + kdst + 32 * 272) = kr[t + 1 < 9 ? t + 1 : 8][1]; }
                asm volatile("s_waitcnt lgkmcnt(0)" ::: "memory"); __builtin_amdgcn_s_barrier(); asm volatile("" ::: "memory");
            }
#undef ATT_S
            const unsigned char* Vg = (const unsigned char*)(VT + (size_t)(h * 128 + (tid >> 3)) * MTOK + b * 4096 + rsU * 64) + (tid & 7) * 16;
#pragma unroll
            for (int j = 0; j < 9; ++j) if (j < nU) { kr[j][0] = *(const v4u*)(Vg + j * 128); kr[j][1] = *(const v4u*)(Vg + j * 128 + (size_t)64 * MTOK * 2); }
            const int c = cb * 16 + j16, cs = min(max(c - 8, 0), 48);
            const float scale = 0.08838834764831845f;
            const LAS float* bl = rpb_l + h * 465 + (rs - r + 7) * 31;
            float mx = -3.0e38f;
#pragma unroll
            for (int i = 0; i < 8; ++i)
#pragma unroll
                for (int tl = 0; tl < 2; ++tl)
#pragma unroll
                    for (int t = 0; t < 4; ++t) {
                        const int kc = kc0 + 8 * kq + 4 * tl + t; const bool inw = (kc >= cs) && (kc < cs + 16);
                        const int rel = min(max(kc - c + 15, 0), 30);
                        float v = sc[i][tl][t] * scale + bl[i * 31 + rel]; v = inw ? v : -1e30f; sc[i][tl][t] = v; mx = fmaxf(mx, v);
                    }
            mx = fmaxf(mx, __shfl_xor(mx, 16)); mx = fmaxf(mx, __shfl_xor(mx, 32));
            float sum = 0.f;
#pragma unroll
            for (int i = 0; i < 8; ++i)
#pragma unroll
                for (int tl = 0; tl < 2; ++tl)
#pragma unroll
                    for (int t = 0; t < 4; ++t) { const float pe = __builtin_amdgcn_exp2f((sc[i][tl][t] - mx) * 1.4426950408889634f); sc[i][tl][t] = pe; sum += pe; }
            sum += __shfl_xor(sum, 16); sum += __shfl_xor(sum, 32);
            f32x4 oacc[8];
#pragma unroll
            for (int dt = 0; dt < 8; ++dt) oacc[dt] = (f32x4){0.f, 0.f, 0.f, 0.f};
            *(LAS v4u*)(ring + vdst) = kr[0][0]; *(LAS v4u*)(ring + vdst + 64 * 144) = kr[0][1];
            asm volatile("s_waitcnt lgkmcnt(0)" ::: "memory"); __builtin_amdgcn_s_barrier(); asm volatile("" ::: "memory");
            const int voff = j16 * 144 + (kc0 + 8 * kq) * 2;
#define ATT_PV(I, BUF) do { u32x4 pw_; pw_.x = cvt_pk_bf16(sc[I][0][0], sc[I][0][1]); pw_.y = cvt_pk_bf16(sc[I][0][2], sc[I][0][3]); pw_.z = cvt_pk_bf16(sc[I][1][0], sc[I][1][1]); pw_.w = cvt_pk_bf16(sc[I][1][2], sc[I][1][3]); \
                const bf16x8 pf_ = __builtin_bit_cast(bf16x8, pw_); \
                _Pragma("unroll") for (int dt = 0; dt < 8; ++dt) { const bf16x8 vf_ = *(const LAS bf16x8*)((BUF) + voff + dt * 16 * 144); oacc[dt] = __builtin_amdgcn_mfma_f32_16x16x32_bf16(vf_, pf_, oacc[dt], 0, 0, 0); } } while (0)
#pragma unroll
            for (int t = 0; t < 9; ++t) if (t < nU) {
                const LAS unsigned char* buf = ring + (t & 1) * SLOT;
                if (dsh == 0) { if (t < 8) ATT_PV(t < 8 ? t : 0, buf); } else { if (t >= 1) ATT_PV(t >= 1 ? t - 1 : 0, buf); }
                if (t + 1 < nU) { LAS unsigned char* nb = ring + ((t + 1) & 1) * SLOT; *(LAS v4u*)(nb + vdst) = kr[t + 1 < 9 ? t + 1 : 8][0]; *(LAS v4u*)(nb + vdst + 64 * 144) = kr[t + 1 < 9 ? t + 1 : 8][1]; }
                asm volatile("s_waitcnt lgkmcnt(0)" ::: "memory"); __builtin_amdgcn_s_barrier(); asm volatile("" ::: "memory");
            }
#undef ATT_PV
            const float inv = 1.f / sum; float ss = 0.f;
#pragma unroll
            for (int dt = 0; dt < 8; ++dt) { oacc[dt] = oacc[dt] * inv; ss += (oacc[dt][0] * oacc[dt][0] + oacc[dt][1] * oacc[dt][1]) + (oacc[dt][2] * oacc[dt][2] + oacc[dt][3] * oacc[dt][3]); }
            ss += __shfl_xor(ss, 16); ss += __shfl_xor(ss, 32);
            const float rn = rsqrtf(ss * (1.f / 128.f) + EPS);
            bf16_t* Op = MIX + (size_t)(b * 4096 + r * 64 + c) * DM + h * 128 + 4 * kq;
#pragma unroll
            for (int dt = 0; dt < 8; ++dt) { const f32x4 gn = *(const f32x4*)(g_attn + h * 128 + 16 * dt + 4 * kq); const f32x4 o = oacc[dt] * rn * gn;
                v2u w; w.x = cvt_pk_bf16(o[0], o[1]); w.y = cvt_pk_bf16(o[2], o[3]); *(v2u*)(Op + 16 * dt) = w; }
        }
        for (int it = gw; it < 2048; it += NGW) {
            const int half = it & 1, row0 = (it >> 1) * 8, ch = half * 512 + lane * 8;
            float w0[8], w1[8], w2[8], bb[8], gn[8];
#pragma unroll
            for (int q = 0; q < 2; ++q) {
                const f32x4 t0 = *(const f32x4*)(a.in[9] + ch + 4 * q), t1 = *(const f32x4*)(a.in[9] + 1024 + ch + 4 * q), t2 = *(const f32x4*)(a.in[9] + 2048 + ch + 4 * q);
                const f32x4 t3 = *(const f32x4*)(a.in[10] + ch + 4 * q), t4 = *(const f32x4*)(a.in[12] + ch + 4 * q);
#pragma unroll
                for (int e = 0; e < 4; ++e) { w0[4 * q + e] = t0[e]; w1[4 * q + e] = t1[e]; w2[4 * q + e] = t2[e]; bb[4 * q + e] = t3[e]; gn[4 * q + e] = t4[e]; }
            }
            const bf16_t* Gr = GB + (size_t)row0 * NGRP;
            float xp[8], xc[8], xn[8];
            conv_ldx(Gr - NGRP, ch, (row0 & 4095) != 0, xp);
            conv_ldx(Gr, ch, true, xc);
#pragma unroll
            for (int tk = 0; tk < 8; ++tk) {
                const int row = row0 + tk;
                conv_ldx(Gr + (size_t)(tk + 1) * NGRP, ch, (row & 4095) != 4095, xn);
                const v4u gbv = __builtin_nontemporal_load((const v4u*)(Gr + (size_t)tk * NGRP + ch));
                float gbf[8] = {bf_lo(gbv.x), bf_hi(gbv.x), bf_lo(gbv.y), bf_hi(gbv.y), bf_lo(gbv.z), bf_hi(gbv.z), bf_lo(gbv.w), bf_hi(gbv.w)};
                float y[8]; float ss = 0.f;
#pragma unroll
                for (int e = 0; e < 8; ++e) { y[e] = gbf[e] * (w0[e] * xp[e] + w1[e] * xc[e] + w2[e] * xn[e] + bb[e]); ss += y[e] * y[e]; }
                ss += __shfl_xor(ss, 1); ss += __shfl_xor(ss, 2); ss += __shfl_xor(ss, 4); ss += __shfl_xor(ss, 8);
                const float rn = rsqrtf(ss * (1.f / 128.f) + EPS);
                v4u w; w.x = cvt_pk_bf16(y[0] * rn * gn[0], y[1] * rn * gn[1]); w.y = cvt_pk_bf16(y[2] * rn * gn[2], y[3] * rn * gn[3]);
                w.z = cvt_pk_bf16(y[4] * rn * gn[4], y[5] * rn * gn[5]); w.w = cvt_pk_bf16(y[6] * rn * gn[6], y[7] * rn * gn[7]);
                *(v4u*)(MIX + (size_t)row * DM + 1024 + ch) = w;
#pragma unroll
                for (int e = 0; e < 8; ++e) { xp[e] = xc[e]; xc[e] = xn[e]; }
            }
        }
        __syncthreads();
    }
    xcd_barrier(bar, wave == 0 && pg8::lane_id_v() == 0);
    { pg8::Gemm g{MIX, WOUT, MTOK, DM, DM}; pg8::StaticOrder S; S.init(MTOK, DM, G, bid); EpiResidL<true> E{HB, ws + WS_HB8, ssq2, 1.0f};
      pg8::gemm_phase<EpiResidL<true>, pg8::StaticOrder, true, true>(lds, g, S, E, wave); }
    { pg8::Gemm g{PB, WPLE, MTOK, DM, PLE}; pg8::StaticOrder S; S.init(MTOK, DM, G, bid); EpiCol E{PROJ, DM, nullptr};
      pg8::gemm_phase<EpiCol, pg8::StaticOrder, true, true>(lds, g, S, E, wave); }
    xcd_barrier(bar, wave == 0 && pg8::lane_id_v() == 0);
    { pg8::Gemm g{(const bf16_t*)(ws + WS_HB8), WGU2, MTOK, 2 * FF, DM / 2}; pg8::StaticOrder S; S.init(MTOK, 2 * FF, G, bid); EpiSwiGLU<true> E{ACT, ssq2, 1.0f / (H_SCALE * WD_SCALE)};
      pg8::gemm_phase<EpiSwiGLU<true>, pg8::StaticOrder, true, true, true>(lds, g, S, E, wave); }
    tr_idle(a, ws, lds, wave, bid, G, (MTOK / 256) * (2 * FF / 256), TW_END_B, TW_NITEMS);
    xcd_barrier(bar, wave == 0 && pg8::lane_id_v() == 0);
    { pg8::Gemm g{(const bf16_t*)ACT, WD2, MTOK, DM, FF / 2}; pg8::StaticOrder S; S.init(MTOK, DM, G, bid); EpiResidL<false> E{HB, nullptr, ssq3, 0.5f / (ACT_SCALE * WD_SCALE)};
      pg8::gemm_phase<EpiResidL<false>, pg8::StaticOrder, true, true, true>(lds, g, S, E, wave); }
    xcd_barrier(bar, wave == 0 && pg8::lane_id_v() == 0);
    { pg8::Gemm g{HB, WGATE, MTOK, DM, DM}; pg8::StaticOrder S; S.init(MTOK, DM, G, bid); EpiPleNorm E{HB, out, PROJ, ssq3, ssq4, pcnt, a.in[21], 1.0f};
      pg8::gemm_phase<EpiPleNorm, pg8::StaticOrder, true, true, false>(lds, g, S, E, wave); }
}

extern "C" void kernel_launch(void* const* d_in, const int* in_sizes, int n_in, void* d_out, int out_size, void* d_ws, size_t ws_size, hipStream_t stream) {
    static int grid = 0;
    if (grid == 0) {
        if (n_in != 22 || out_size != MTOK * DM || ws_size < WS_END) { fprintf(stderr, "kernel_launch: unexpected shapes (n_in %d out %d ws %zu)\n", n_in, out_size, ws_size); grid = -1; return; }
        int dev = 0, cus = 0, per_cu = 0;
        (void)hipGetDevice(&dev);
        (void)hipDeviceGetAttribute(&cus, hipDeviceAttributeMultiprocessorCount, dev);
        (void)hipFuncSetAttribute((const void*)mk_fwd, hipFuncAttributeMaxDynamicSharedMemorySize, LDS_BYTES);
        (void)hipOccupancyMaxActiveBlocksPerMultiprocessor(&per_cu, (const void*)mk_fwd, 512, LDS_BYTES);
        (void)hipGetLastError();
        grid = cus > 0 ? cus : 256;
    }
    if (grid < 0) return;
    if (hipMemsetAsync((unsigned char*)d_ws + WS_BAR, 0, XCD_BAR_WORDS * 4, stream) != hipSuccess) { fprintf(stderr, "kernel_launch: memset of the barrier words failed\n"); return; }
    Args a{};
    for (int i = 0; i < 22; ++i) a.in[i] = (const float*)d_in[i];
    a.out = (float*)d_out; a.ws = (unsigned char*)d_ws;
    void* args[] = {&a};
    hipError_t e = hipLaunchCooperativeKernel((const void*)mk_fwd, dim3(grid), dim3(512), args, LDS_BYTES, stream);
    if (e != hipSuccess) fprintf(stderr, "cooperative launch failed: %s (grid %d)\n", hipGetErrorString(e), grid);
}
```

```cpp
#include <hip/hip_runtime.h>
#include <hip/hip_cooperative_groups.h>
#include <cstdio>
#include <cstdint>
namespace cg = cooperative_groups;
namespace pg8 {
#define PG8_LAS __attribute__((address_space(3)))
typedef unsigned short bf16_t;
typedef short bf16x8 __attribute__((ext_vector_type(8)));
typedef float f32x4 __attribute__((ext_vector_type(4)));
typedef unsigned u32x4 __attribute__((ext_vector_type(4)));
constexpr int BM = 256, BK = 64, HALF = 128, HTB = HALF * BK * 2  , STAGE_BYTES = 8 * HTB, NXCD = 8, WGM = 8;

__host__ __device__ __forceinline__ int lds_byte(int r, int c) { const int st = (r >> 4) * 2 + (c >> 5), rr = r & 15, cc = c & 31, ob = rr * 64 + cc * 2; return st * 1024 + (ob ^ (((ob >> 9) & 1) << 5)); }
__host__ __device__ __forceinline__ void stage_rc(int b, int& R, int& C) { const int st = b / 1024, sb = b % 1024, swz = sb ^ (((sb >> 9) & 1) << 5); R = (st >> 1) * 16 + swz / 64; C = (st & 1) * 32 + (swz % 64) / 2; }
__host__ __device__ __forceinline__ int perm32(int rho) { const int n = rho >> 4, i = rho & 15; return 8 * (i >> 2) + 4 * n + (i & 3); }

struct Unit { int pm, pn; };
struct Gemm { const bf16_t* A; const bf16_t* Bt; int M, N, K; };

struct StaticOrder {
    int nM, nN, nwg, G, c;
    __host__ __device__ void init(int M, int N, int G_, int c_) { nM = M / BM; nN = N / BM; nwg = nM * nN; G = G_; c = c_; }
    __host__ __device__ bool next(int i, Unit& u) const {
        const long L = (long)i * G + c; if (L >= nwg) return false;
        int wgid = (int)L; { const int q = nwg / NXCD, r = nwg % NXCD, xcd = wgid % NXCD, off = wgid / NXCD; wgid = (xcd < r ? xcd * (q + 1) : r * (q + 1) + (xcd - r) * q) + off; }
        const int nig = WGM * nN, gid = wgid / nig, fm = gid * WGM, gsz = (nM - fm) < WGM ? (nM - fm) : WGM;
        u.pm = fm + ((wgid % nig) % gsz); u.pn = (wgid % nig) / gsz; return true;
    }
    __device__ __forceinline__ void a_ready(const Unit&) const {}
    __device__ __forceinline__ void done(const Unit&) const {}
};

__device__ __forceinline__ unsigned cvt_pk_bf16(float lo, float hi) { unsigned r; asm volatile("v_cvt_pk_bf16_f32 %0, %1, %2" : "=v"(r) : "v"(lo), "v"(hi)); return r; }
__device__ __forceinline__ int lane_id_v() { int l; asm volatile("v_mbcnt_lo_u32_b32 %0, -1, 0\n\tv_mbcnt_hi_u32_b32 %0, -1, %0" : "=v"(l)); return l; }
typedef int i32x4v __attribute__((ext_vector_type(4)));
typedef int i32x8v __attribute__((ext_vector_type(8)));
template <class Epi, class Sched, bool ALIGN_EPI = false, bool SP2 = false, bool FP8 = false>
__device__ __forceinline__ void gemm_phase(PG8_LAS unsigned char* lds, const Gemm g, const Sched& S, const Epi& E, const int wid  ) {
    const int lane = lane_id_v(), tid = wid * 64 + lane, wr = wid >> 2, wc = wid & 3, fr = lane & 15, fq = lane >> 4;
    int sc1 = 0x7F7F7F7F; asm volatile("" : "+v"(sc1));
    const int K = g.K, nt = K / BK;
    unsigned voffA[2], voffB[2];
#pragma unroll
    for (int i = 0; i < 2; ++i) { int R, C; stage_rc(tid * 16 + i * 8192, R, C); const int Rb = Epi::PERM ? ((R & ~31) + perm32(R & 31)) : R;
        voffA[i] = (unsigned)(R * K + C) * 2u; voffB[i] = (unsigned)(Rb * K + C) * 2u; }
    const size_t kstep = (size_t)(BK * 2);
    size_t hstep = (size_t)HALF * K * 2;
    const size_t tstep = 2 * hstep;
    const unsigned ldsw = (unsigned)wid * 1024u;
    const int aoff = lds_byte(wr * 64 + fr, fq * 8), boff = lds_byte(wc * 32 + fr, fq * 8);
#define PG8_SA(b, h) (((b) * 2 + (h)) * HTB)
#define PG8_SB(b, h) ((4 + (b) * 2 + (h)) * HTB)
#define PG8_STAGE(bufoff, gbase, voff) do { _Pragma("unroll") for (int _i = 0; _i < 2; ++_i) \
        __builtin_amdgcn_global_load_lds((const unsigned*)((const char*)(gbase) + (voff)[_i]), (PG8_LAS unsigned*)(lds + (bufoff) + ldsw + _i * 8192), 16, 0, 0); } while (0)
#define PG8_LDA(dst, b, h) do { if constexpr (FP8) { _Pragma("unroll") for (int m = 0; m < 4; ++m) { const i32x4v lo_ = *(const PG8_LAS i32x4v*)(lds + PG8_SA(b, h) + aoff + m * 2048), hi_ = *(const PG8_LAS i32x4v*)(lds + PG8_SA(b, h) + aoff + m * 2048 + 1024); dst##8[m] = __builtin_shufflevector(lo_, hi_, 0, 1, 2, 3, 4, 5, 6, 7); } } else { \
        _Pragma("unroll") for (int m = 0; m < 4; ++m) _Pragma("unroll") for (int k = 0; k < 2; ++k) dst[m][k] = *(const PG8_LAS bf16x8*)(lds + PG8_SA(b, h) + aoff + m * 2048 + k * 1024); } } while (0)
#define PG8_LDB(dst, b, h) do { if constexpr (FP8) { _Pragma("unroll") for (int n = 0; n < 2; ++n) { const i32x4v lo_ = *(const PG8_LAS i32x4v*)(lds + PG8_SB(b, h) + boff + n * 2048), hi_ = *(const PG8_LAS i32x4v*)(lds + PG8_SB(b, h) + boff + n * 2048 + 1024); dst##8[n] = __builtin_shufflevector(lo_, hi_, 0, 1, 2, 3, 4, 5, 6, 7); } } else { \
        _Pragma("unroll") for (int n = 0; n < 2; ++n) _Pragma("unroll") for (int k = 0; k < 2; ++k) dst[n][k] = *(const PG8_LAS bf16x8*)(lds + PG8_SB(b, h) + boff + n * 2048 + k * 1024); } } while (0)
#define PG8_MMA(ai, bj, Af, Bf) do { __builtin_amdgcn_s_setprio(1); if constexpr (FP8) { _Pragma("unroll") for (int m = 0; m < 4; ++m) _Pragma("unroll") for (int n = 0; n < 2; ++n) \
        asm volatile("v_mfma_scale_f32_16x16x128_f8f6f4 %0, %1, %2, %0, %3, %3 op_sel_hi:[0,0,0]" : "+v"(acc[ai][bj][m][n]) : "v"(Bf##8[n]), "v"(Af##8[m]), "v"(sc1)); } else { \
        _Pragma("unroll") for (int m = 0; m < 4; ++m) _Pragma("unroll") for (int n = 0; n < 2; ++n) _Pragma("unroll") for (int k = 0; k < 2; ++k) \
        acc[ai][bj][m][n] = __builtin_amdgcn_mfma_f32_16x16x32_bf16(Bf[n][k], Af[m][k], acc[ai][bj][m][n], 0, 0, 0); } __builtin_amdgcn_s_setprio(0); } while (0)
#define PG8_WAIT_V(n) asm volatile("s_waitcnt vmcnt(" #n ")" ::: "memory")
#define PG8_WAIT_L(n) asm volatile("s_waitcnt lgkmcnt(" #n ")" ::: "memory")
#define PG8_BAR __builtin_amdgcn_s_barrier()
#define PG8_SCHED __builtin_amdgcn_sched_barrier(0)
    Unit cur, nxt; int ui = 0;
    if (!S.next(0, cur)) return;
    f32x4 acc[2][2][4][2];
#pragma unroll
    for (int a = 0; a < 2; ++a)
#pragma unroll
        for (int b = 0; b < 2; ++b)
#pragma unroll
            for (int m = 0; m < 4; ++m)
#pragma unroll
                for (int n = 0; n < 2; ++n) acc[a][b][m][n] = (f32x4){0.f, 0.f, 0.f, 0.f};
    bf16x8 At[4][2], B0[2][2], B1[2][2]; i32x8v At8[4], B08[2], B18[2];
    const char* cA = (const char*)g.A + (size_t)cur.pm * tstep; const char* cB = (const char*)g.Bt + (size_t)cur.pn * tstep;
    S.a_ready(cur);
    if constexpr (SP2) {
        PG8_STAGE(PG8_SB(0, 0), cB, voffB); PG8_STAGE(PG8_SB(0, 1), cB + hstep, voffB); PG8_STAGE(PG8_SA(0, 0), cA, voffA); PG8_STAGE(PG8_SA(0, 1), cA + hstep, voffA);
        if (wr == 1) PG8_BAR;
        PG8_WAIT_V(2); PG8_BAR;
        PG8_STAGE(PG8_SB(1, 0), cB + kstep, voffB); PG8_STAGE(PG8_SA(1, 0), cA + kstep, voffA); PG8_STAGE(PG8_SB(1, 1), cB + hstep + kstep, voffB);
        PG8_WAIT_V(6); PG8_BAR;
    } else {
        PG8_STAGE(PG8_SB(0, 0), cB, voffB); PG8_STAGE(PG8_SA(0, 0), cA, voffA); PG8_STAGE(PG8_SB(0, 1), cB + hstep, voffB); PG8_STAGE(PG8_SA(0, 1), cA + hstep, voffA);
        if (wr == 1) PG8_BAR;
        PG8_WAIT_V(4); PG8_BAR;
        PG8_STAGE(PG8_SB(1, 0), cB + kstep, voffB); PG8_STAGE(PG8_SA(1, 0), cA + kstep, voffA); PG8_STAGE(PG8_SB(1, 1), cB + hstep + kstep, voffB);
        PG8_WAIT_V(6); PG8_BAR;
    }
    for (;;) {
        const bool has_next = S.next(ui + 1, nxt);
        const char* nA = has_next ? (const char*)g.A + (size_t)nxt.pm * tstep : cA; const char* nB = has_next ? (const char*)g.Bt + (size_t)nxt.pn * tstep : cB;
        if constexpr (Epi::RESID_DMA) { if (!has_next) { nA = E.resid_tile(cur); nB = nA + 256; } }
        for (int t = 0; t < nt; t += 2) {
            const bool last = (t == nt - 2);
            const char* a1 = cA + (size_t)(t + 1) * kstep;
            const char* a2 = last ? nA : cA + (size_t)(t + 2) * kstep; const char* b2 = last ? nB : cB + (size_t)(t + 2) * kstep;
            const char* a3 = a2 + kstep; const char* b3 = b2 + kstep;
            if (last && has_next) S.a_ready(nxt);
            if constexpr (SP2) {
            PG8_LDB(B0, 0, 0); PG8_LDB(B1, 0, 1); PG8_SCHED; PG8_LDA(At, 0, 0); PG8_STAGE(PG8_SA(1, 1), a1 + hstep, voffA);
            PG8_WAIT_V(8); PG8_WAIT_L(0); PG8_BAR; PG8_MMA(0, 0, At, B0); PG8_MMA(0, 1, At, B1); PG8_BAR; PG8_SCHED;
            if constexpr (Epi::RESID_DMA) { if (last && !has_next) {
                _Pragma("unroll") for (int i = 0; i < 2; ++i) { int R, C; stage_rc(tid * 16 + i * 8192, R, C); voffA[i] = voffB[i] = (unsigned)(R * 2048 + C) * 2u; }
                hstep = (size_t)HALF * 2048 * 2; } }
            PG8_LDA(At, 0, 1); PG8_STAGE(PG8_SB(0, 0), b2, voffB); PG8_STAGE(PG8_SB(0, 1), b2 + hstep, voffB); PG8_STAGE(PG8_SA(0, 0), a2, voffA);
            PG8_WAIT_V(8); PG8_WAIT_L(0); PG8_BAR; PG8_MMA(1, 0, At, B0); PG8_MMA(1, 1, At, B1); PG8_BAR; PG8_SCHED;
            PG8_LDB(B0, 1, 0); PG8_LDB(B1, 1, 1); PG8_SCHED; PG8_LDA(At, 1, 0); PG8_STAGE(PG8_SA(0, 1), a2 + hstep, voffA);
            PG8_WAIT_V(8); PG8_WAIT_L(0); PG8_BAR; PG8_MMA(0, 0, At, B0); PG8_MMA(0, 1, At, B1); PG8_BAR; PG8_SCHED;
            PG8_LDA(At, 1, 1); PG8_STAGE(PG8_SB(1, 0), b3, voffB); PG8_STAGE(PG8_SB(1, 1), b3 + hstep, voffB); PG8_STAGE(PG8_SA(1, 0), a3, voffA);
            PG8_WAIT_V(8); PG8_WAIT_L(0); PG8_BAR; PG8_MMA(1, 0, At, B0); PG8_MMA(1, 1, At, B1); PG8_BAR; PG8_SCHED;
            } else {
            PG8_LDB(B0, 0, 0); PG8_SCHED; PG8_LDA(At, 0, 0); PG8_STAGE(PG8_SA(1, 1), a1 + hstep, voffA);
            PG8_WAIT_L(8); PG8_BAR; PG8_WAIT_L(0); PG8_MMA(0, 0, At, B0); PG8_BAR; PG8_SCHED;
            PG8_LDB(B1, 0, 1); PG8_STAGE(PG8_SB(0, 0), b2, voffB);
            PG8_BAR; PG8_WAIT_L(0); PG8_MMA(0, 1, At, B1); PG8_BAR;
            PG8_LDA(At, 0, 1); PG8_STAGE(PG8_SA(0, 0), a2, voffA);
            PG8_BAR; PG8_WAIT_L(0); PG8_MMA(1, 0, At, B0); PG8_BAR; PG8_SCHED;
            PG8_STAGE(PG8_SB(0, 1), b2 + hstep, voffB);
            PG8_WAIT_V(6); PG8_BAR; PG8_MMA(1, 1, At, B1); PG8_BAR;
            PG8_LDB(B0, 1, 0); PG8_SCHED; PG8_LDA(At, 1, 0); PG8_STAGE(PG8_SA(0, 1), a2 + hstep, voffA);
            PG8_WAIT_L(8); PG8_BAR; PG8_WAIT_L(0); PG8_MMA(0, 0, At, B0); PG8_BAR; PG8_SCHED;
            PG8_LDB(B1, 1, 1); PG8_STAGE(PG8_SB(1, 0), b3, voffB);
            PG8_BAR; PG8_WAIT_L(0); PG8_MMA(0, 1, At, B1); PG8_BAR;
            PG8_LDA(At, 1, 1); PG8_STAGE(PG8_SA(1, 0), a3, voffA);
            PG8_BAR; PG8_WAIT_L(0); PG8_MMA(1, 0, At, B0); PG8_BAR; PG8_SCHED;
            PG8_STAGE(PG8_SB(1, 1), b3 + hstep, voffB);
            PG8_WAIT_V(6); PG8_BAR; PG8_MMA(1, 1, At, B1); PG8_BAR;
            }
        }
        if constexpr (ALIGN_EPI) { if (wr == 0) PG8_BAR; }
        if constexpr (FP8) asm volatile("s_nop 15\n\ts_nop 15\n\ts_nop 15" ::: "memory");
        if constexpr (!Epi::AFTER_DRAIN) { E(acc, cur, wr, wc, fr, fq); S.done(cur); }
        if (!has_next) break;
#pragma unroll
        for (int a = 0; a < 2; ++a)
#pragma unroll
            for (int b = 0; b < 2; ++b)
#pragma unroll
                for (int m = 0; m < 4; ++m)
#pragma unroll
                    for (int n = 0; n < 2; ++n) acc[a][b][m][n] = (f32x4){0.f, 0.f, 0.f, 0.f};
        cur = nxt; cA = nA; cB = nB; ++ui;
        if constexpr (ALIGN_EPI) { if (wr == 1) PG8_BAR; }
    }
    PG8_WAIT_V(0);
    if constexpr (!ALIGN_EPI) { if (wr == 0) PG8_BAR; }
    PG8_BAR;
    if constexpr (Epi::AFTER_DRAIN) { if constexpr (FP8) asm volatile("s_nop 15\n\ts_nop 15\n\ts_nop 15" ::: "memory"); E.fused(acc, cur, wr, wc, fr, fq, lds, wid, lane); S.done(cur); }
#undef PG8_SA
#undef PG8_SB
#undef PG8_STAGE
#undef PG8_LDA
#undef PG8_LDB
#undef PG8_MMA
#undef PG8_WAIT_V
#undef PG8_WAIT_L
#undef PG8_BAR
#undef PG8_SCHED
}
}

#define LAS __attribute__((address_space(3)))
using pg8::bf16_t; using pg8::bf16x8; using pg8::f32x4; using pg8::u32x4; using pg8::cvt_pk_bf16;
typedef unsigned v4u __attribute__((ext_vector_type(4)));
typedef unsigned v2u __attribute__((ext_vector_type(2)));
constexpr int MTOK = 8192, DM = 2048, FF = 5632, SEQ = 4096, PLE = 256, NGRP = 3072;
constexpr float EPS = 1e-6f;
constexpr float ACT_SCALE = 8.f, WD_SCALE = 1024.f, H_SCALE = 16.f;
constexpr size_t MiB = 1u << 20;
constexpr size_t WS_SSQ = 0, WS_WGU1 = 1 * MiB, WS_WD1 = 45 * MiB, WS_WIN = 67 * MiB, WS_WINV = 87 * MiB, WS_WOUT = 91 * MiB, WS_WGU2 = 99 * MiB, WS_WD2 = 143 * MiB,
                 WS_WGATE = 165 * MiB, WS_WPLE = 173 * MiB, WS_HB = 174 * MiB, WS_PB = 206 * MiB, WS_ACT = 210 * MiB, WS_QK = 210 * MiB, WS_VT = 242 * MiB, WS_MIX = 258 * MiB,
                 WS_G = 298 * MiB, WS_PROJ = 298 * MiB, WS_HB8 = 330 * MiB  , WS_END = 346 * MiB;
constexpr size_t QK_STRIDE = (size_t)MTOK * 1024;
constexpr int LDS_BYTES = 147456, LDS_MISC = 147392;
constexpr size_t WS_BAR = 512 * 1024;


__device__ __forceinline__ float bf_lo(unsigned w) { return __uint_as_float(w << 16); }
__device__ __forceinline__ float bf_hi(unsigned w) { return __uint_as_float(w & 0xffff0000u); }
__device__ __forceinline__ float rs_of(float ssq) { return rsqrtf(ssq * (1.f / 2048.f) + EPS); }
__device__ __forceinline__ float f8_clamp(float x) { return __builtin_amdgcn_fmed3f(x, -448.0f, 448.0f); }
__device__ __forceinline__ float sigmoid_f(float x) { return __builtin_amdgcn_rcpf(1.f + __builtin_amdgcn_exp2f(-1.4426950408889634f * x)); }
__device__ __forceinline__ float wave_sum(float v) {
#pragma unroll
    for (int o = 1; o < 64; o <<= 1) v += __shfl_xor(v, o);
    return v;
}

#define XB_LAS LAS
#define XB_TMO      128
#define XB_XCNT(j)  (256  + 64 * (j))
#define XB_XSUB(j)  (1280 + 64 * (j))
#define XB_XGEN(j)  (2304 + 64 * (j))
#define XB_TOP      3328
#define XB_TOPGEN   3392
#define XCD_BAR_WORDS 3456
#define XB_SPIN_CAP (1u << 18)

__device__ __forceinline__ unsigned xb_ld(unsigned* p)              { return __hip_atomic_load(p, __ATOMIC_RELAXED, __HIP_MEMORY_SCOPE_AGENT); }
__device__ __forceinline__ unsigned xb_add(unsigned* p, unsigned v) { return __hip_atomic_fetch_add(p, v, __ATOMIC_RELAXED, __HIP_MEMORY_SCOPE_AGENT); }
__device__ __forceinline__ unsigned xb_xcc_id() { return (unsigned)__builtin_amdgcn_s_getreg((3 << 11) | 20) & 0xFu; }
#define XB_SPIN(cond, bar) do { unsigned _sp = 0; while (cond) { __builtin_amdgcn_s_sleep(1); \
    if ((++_sp & 255u) == 0u) { if (xb_ld(&(bar)[XB_TMO])) break; if (_sp > XB_SPIN_CAP) { atomicAdd(&(bar)[XB_TMO], 1u); break; } } } } while (0)

struct XcdBarrier {
    unsigned* bar; unsigned x;
    volatile LAS unsigned* st;
};

__device__ __forceinline__ XcdBarrier xcd_barrier_post(unsigned* bar, volatile LAS unsigned* st, const bool leader_) {
    XcdBarrier b; b.bar = bar; b.x = xb_xcc_id(); b.st = st;
    if (leader_) (void)xb_add(&bar[XB_XCNT(b.x)], 1u);
    return b;
}
__device__ __forceinline__ void xcd_barrier_complete(unsigned* bar, unsigned x, unsigned& nloc, unsigned& nx) {
    const unsigned G = gridDim.x * gridDim.y * gridDim.z;
    unsigned sum, cnt, mine, sp = 0u;
    for (;;) {
        sum = 0u; cnt = 0u; mine = 0u;
#pragma unroll
        for (unsigned j = 0; j < 16; ++j) { const unsigned c = xb_ld(&bar[XB_XCNT(j)]); sum += c; cnt += (c > 0u) ? 1u : 0u; mine = (j == x) ? c : mine; }
        if (sum == G) break;
        __builtin_amdgcn_s_sleep(1);
        if ((++sp & 255u) == 0u) { if (xb_ld(&bar[XB_TMO])) break; if (sp > XB_SPIN_CAP) { atomicAdd(&bar[XB_TMO], 1u); break; } }
    }
    nloc = mine > 0u ? mine : 1u; nx = cnt > 0u ? cnt : 1u;
}

__device__ __forceinline__ void xcd_barrier(const XcdBarrier& b, const bool leader_) {
    asm volatile("s_waitcnt vmcnt(0)" ::: "memory");
    __syncthreads();
    if (leader_) {
        unsigned* bar = b.bar;
        __builtin_amdgcn_s_waitcnt(0);
        unsigned nloc = b.st[0], nx = b.st[1];
        if (nloc == 0u) { xcd_barrier_complete(bar, b.x, nloc, nx); b.st[0] = nloc; b.st[1] = nx; }
        const unsigned old = xb_add(&bar[XB_XSUB(b.x)], 1u);
        const unsigned gen = old / nloc;
        if (old + 1u == (gen + 1u) * nloc) {
            __builtin_amdgcn_fence(__ATOMIC_RELEASE, "agent");
            asm volatile("s_waitcnt vmcnt(0)" ::: "memory");
            const unsigned og = xb_add(&bar[XB_TOP], 1u);
            const unsigned tg = og / nx;
            if (og + 1u == (tg + 1u) * nx) xb_add(&bar[XB_TOPGEN], 1u);
            else XB_SPIN(xb_ld(&bar[XB_TOPGEN]) == tg, bar);
            __builtin_amdgcn_fence(__ATOMIC_ACQUIRE, "agent");
            xb_add(&bar[XB_XGEN(b.x)], 1u);
            asm volatile("s_waitcnt vmcnt(0)" ::: "memory");
        } else {
            XB_SPIN(xb_ld(&bar[XB_XGEN(b.x)]) == gen, bar);
            __builtin_amdgcn_fence(__ATOMIC_ACQUIRE, "agent");
            asm volatile("s_waitcnt vmcnt(0)" ::: "memory");
        }
    }
    __syncthreads();
}

template <bool F8> struct EpiSwiGLU {
    static constexpr bool PERM = true, AFTER_DRAIN = false, RESID_DMA = false;
    unsigned char* O; const float* ssq; float mul;
    __device__ __forceinline__ void operator()(const f32x4 (&acc)[2][2][4][2], const pg8::Unit& u, int wr, int wc, int fr, int fq) const {
        const int row0 = u.pm * 256 + wr * 64 + fr, col0 = u.pn * 128 + wc * 32 + 8 * fq;
        float sq[2][4];
#pragma unroll
        for (int ai = 0; ai < 2; ++ai)
#pragma unroll
            for (int m = 0; m < 4; ++m) sq[ai][m] = ssq[row0 + ai * 128 + m * 16];
#pragma unroll
        for (int ai = 0; ai < 2; ++ai)
#pragma unroll
            for (int m = 0; m < 4; ++m) {
                const int row = row0 + ai * 128 + m * 16; const float r = rs_of(sq[ai][m]) * mul, rn = r * -1.4426950408889634f, ru = r * (F8 ? ACT_SCALE : 1.f);
                float o[8];
#pragma unroll
                for (int n = 0; n < 2; ++n) {
                    const f32x4 ag = acc[ai][0][m][n], Gv = ag * r, Tv = ag * rn, Uv = acc[ai][1][m][n] * ru;
                    f32x4 Ev; Ev[0] = __builtin_amdgcn_exp2f(Tv[0]); Ev[1] = __builtin_amdgcn_exp2f(Tv[1]); Ev[2] = __builtin_amdgcn_exp2f(Tv[2]); Ev[3] = __builtin_amdgcn_exp2f(Tv[3]);
                    Ev = Ev + 1.0f;
                    f32x4 Sv; Sv[0] = __builtin_amdgcn_rcpf(Ev[0]); Sv[1] = __builtin_amdgcn_rcpf(Ev[1]); Sv[2] = __builtin_amdgcn_rcpf(Ev[2]); Sv[3] = __builtin_amdgcn_rcpf(Ev[3]);
                    const f32x4 Ov = (Gv * Sv) * Uv;
                    o[4 * n + 0] = Ov[0]; o[4 * n + 1] = Ov[1]; o[4 * n + 2] = Ov[2]; o[4 * n + 3] = Ov[3];
                }
                if constexpr (F8) {
                int w0 = __builtin_amdgcn_cvt_pk_fp8_f32(f8_clamp(o[0]), f8_clamp(o[1]), 0, false); w0 = __builtin_amdgcn_cvt_pk_fp8_f32(f8_clamp(o[2]), f8_clamp(o[3]), w0, true);
                int w1 = __builtin_amdgcn_cvt_pk_fp8_f32(f8_clamp(o[4]), f8_clamp(o[5]), 0, false); w1 = __builtin_amdgcn_cvt_pk_fp8_f32(f8_clamp(o[6]), f8_clamp(o[7]), w1, true);
                v2u w; w.x = (unsigned)w0; w.y = (unsigned)w1;
                *(v2u*)(O + (size_t)row * FF + col0) = w;
                } else {
                u32x4 w; w.x = cvt_pk_bf16(o[0], o[1]); w.y = cvt_pk_bf16(o[2], o[3]); w.z = cvt_pk_bf16(o[4], o[5]); w.w = cvt_pk_bf16(o[6], o[7]);
                *(u32x4*)((bf16_t*)O + (size_t)row * FF + col0) = w; }
            }
    }
};
template <bool RES16, bool OUT8> struct EpiResid {
    static constexpr bool PERM = true, AFTER_DRAIN = false, RESID_DMA = false;
    const float* R; bf16_t* HB; unsigned char* HB8; float* ssq; float alpha;
    __device__ __forceinline__ void operator()(const f32x4 (&acc)[2][2][4][2], const pg8::Unit& u, int wr, int wc, int fr, int fq) const {
        const int row0 = u.pm * 256 + wr * 64 + fr, col0 = u.pn * 256 + wc * 32 + 8 * fq;
#pragma unroll
        for (int ai = 0; ai < 2; ++ai)
#pragma unroll
            for (int m = 0; m < 4; ++m) {
                const int row = row0 + ai * 128 + m * 16; float s = 0.f;
#pragma unroll
                for (int bj = 0; bj < 2; ++bj) {
                    const size_t off = (size_t)row * DM + col0 + bj * 128;
                    f32x4 r0, r1;
                    if constexpr (RES16) { const v4u q = *(const v4u*)(HB + off); r0 = (f32x4){bf_lo(q.x), bf_hi(q.x), bf_lo(q.y), bf_hi(q.y)}; r1 = (f32x4){bf_lo(q.z), bf_hi(q.z), bf_lo(q.w), bf_hi(q.w)}; }
                    else { r0 = __builtin_nontemporal_load((const f32x4*)(R + off)); r1 = __builtin_nontemporal_load((const f32x4*)(R + off + 4)); }
                    const f32x4 v0 = r0 + acc[ai][bj][m][0] * alpha, v1 = r1 + acc[ai][bj][m][1] * alpha;
                    if constexpr (OUT8) {
                        int w0 = __builtin_amdgcn_cvt_pk_fp8_f32(f8_clamp(v0[0] * H_SCALE), f8_clamp(v0[1] * H_SCALE), 0, false); w0 = __builtin_amdgcn_cvt_pk_fp8_f32(f8_clamp(v0[2] * H_SCALE), f8_clamp(v0[3] * H_SCALE), w0, true);
                        int w1 = __builtin_amdgcn_cvt_pk_fp8_f32(f8_clamp(v1[0] * H_SCALE), f8_clamp(v1[1] * H_SCALE), 0, false); w1 = __builtin_amdgcn_cvt_pk_fp8_f32(f8_clamp(v1[2] * H_SCALE), f8_clamp(v1[3] * H_SCALE), w1, true);
                        v2u w; w.x = (unsigned)w0; w.y = (unsigned)w1; *(v2u*)(HB8 + off) = w;
                    }
                    { u32x4 w; w.x = cvt_pk_bf16(v0[0], v0[1]); w.y = cvt_pk_bf16(v0[2], v0[3]); w.z = cvt_pk_bf16(v1[0], v1[1]); w.w = cvt_pk_bf16(v1[2], v1[3]);
                      *(u32x4*)(HB + off) = w; }
                    s += (v0[0] * v0[0] + v0[1] * v0[1]) + (v0[2] * v0[2] + v0[3] * v0[3]) + (v1[0] * v1[0] + v1[1] * v1[1]) + (v1[2] * v1[2] + v1[3] * v1[3]);
                }
                s += __shfl_xor(s, 16); s += __shfl_xor(s, 32);
                if (fq == 0) unsafeAtomicAdd(ssq + row, s);
            }
    }
};
template <bool OUT8> struct EpiResidL {
    static constexpr bool PERM = true, AFTER_DRAIN = true, RESID_DMA = true;
    bf16_t* HB; unsigned char* HB8; float* ssq; float alpha;
    __device__ __forceinline__ const char* resid_tile(const pg8::Unit& u) const { return (const char*)(HB + (size_t)(u.pm * 256) * DM + u.pn * 256); }
    __device__ __forceinline__ void fused(f32x4 (&acc)[2][2][4][2], const pg8::Unit& u, int wr, int wc, int fr, int fq, LAS unsigned char* img, int wid, int lane) const {
        const int row0 = u.pm * 256 + wr * 64 + fr, col0 = u.pn * 256 + wc * 32 + 8 * fq;
        bf16_t* gtile = HB + (size_t)(u.pm * 256) * DM + u.pn * 256;
        v4u qm[4];
        if (wc >= 2) {
#pragma unroll
            for (int m = 0; m < 4; ++m) qm[m] = *(const v4u*)(HB + (size_t)(row0 + 128 + m * 16) * DM + col0);
        }
#pragma unroll
        for (int ai = 0; ai < 2; ++ai)
#pragma unroll
            for (int m = 0; m < 4; ++m) {
                const int row = row0 + ai * 128 + m * 16, rl = wr * 64 + m * 16 + fr; float s = 0.f;
#pragma unroll
                for (int bj = 0; bj < 2; ++bj) {
                    const size_t off = (size_t)row * DM + col0 + bj * 128;
                    LAS v4u* slot = (LAS v4u*)(img + ((bj * 2 + (wc >> 1)) * 2 + ai) * 16384 + pg8::lds_byte(rl, (wc & 1) * 32 + fq * 8));
                    v4u q = *slot;
                    if (ai == 1 && bj == 0) { if (wc >= 2) q = qm[m]; }
                    const f32x4 r0 = (f32x4){bf_lo(q.x), bf_hi(q.x), bf_lo(q.y), bf_hi(q.y)}, r1 = (f32x4){bf_lo(q.z), bf_hi(q.z), bf_lo(q.w), bf_hi(q.w)};
                    const f32x4 v0 = r0 + acc[ai][bj][m][0] * alpha, v1 = r1 + acc[ai][bj][m][1] * alpha;
                    if constexpr (OUT8) {
                        int w0 = __builtin_amdgcn_cvt_pk_fp8_f32(f8_clamp(v0[0] * H_SCALE), f8_clamp(v0[1] * H_SCALE), 0, false); w0 = __builtin_amdgcn_cvt_pk_fp8_f32(f8_clamp(v0[2] * H_SCALE), f8_clamp(v0[3] * H_SCALE), w0, true);
                        int w1 = __builtin_amdgcn_cvt_pk_fp8_f32(f8_clamp(v1[0] * H_SCALE), f8_clamp(v1[1] * H_SCALE), 0, false); w1 = __builtin_amdgcn_cvt_pk_fp8_f32(f8_clamp(v1[2] * H_SCALE), f8_clamp(v1[3] * H_SCALE), w1, true);
                        v2u w; w.x = (unsigned)w0; w.y = (unsigned)w1; *(v2u*)(HB8 + off) = w;
                    }
                    { v4u w; w.x = cvt_pk_bf16(v0[0], v0[1]); w.y = cvt_pk_bf16(v0[2], v0[3]); w.z = cvt_pk_bf16(v1[0], v1[1]); w.w = cvt_pk_bf16(v1[2], v1[3]); *slot = w; }
                    s += (v0[0] * v0[0] + v0[1] * v0[1]) + (v0[2] * v0[2] + v0[3] * v0[3]) + (v1[0] * v1[0] + v1[1] * v1[1]) + (v1[2] * v1[2] + v1[3] * v1[3]);
                }
                s += __shfl_xor(s, 16); s += __shfl_xor(s, 32);
                if (fq == 0) unsafeAtomicAdd(ssq + row, s);
            }
        asm volatile("s_waitcnt lgkmcnt(0)" ::: "memory"); __builtin_amdgcn_s_barrier(); asm volatile("" ::: "memory");
        const int rr = wid * 32 + (lane >> 5), cc = lane & 31;
#pragma unroll
        for (int j = 0; j < 16; ++j) { const int r = rr + 2 * j;
            const v4u w = *(const LAS v4u*)(img + ((cc >> 3) * 2 + (r >> 7)) * 16384 + pg8::lds_byte(r & 127, (cc & 7) * 8));
            *(v4u*)(gtile + (size_t)r * DM + cc * 8) = w; }
        asm volatile("s_waitcnt lgkmcnt(0)" ::: "memory"); __builtin_amdgcn_s_barrier(); asm volatile("" ::: "memory");
    }
};
struct EpiWin {
    static constexpr bool PERM = true, AFTER_DRAIN = false, RESID_DMA = false;
    bf16_t* QK; bf16_t* G; const float* ssq;
    __device__ __forceinline__ void operator()(const f32x4 (&acc)[2][2][4][2], const pg8::Unit& u, int wr, int wc, int fr, int fq) const {
        const int row0 = u.pm * 256 + wr * 64 + fr, cin = wc * 32 + 8 * fq;
        float sq[2][4];
#pragma unroll
        for (int ai = 0; ai < 2; ++ai)
#pragma unroll
            for (int m = 0; m < 4; ++m) sq[ai][m] = ssq[row0 + ai * 128 + m * 16];
#pragma unroll
        for (int ai = 0; ai < 2; ++ai)
#pragma unroll
            for (int m = 0; m < 4; ++m) {
                const int row = row0 + ai * 128 + m * 16; const float r = rs_of(sq[ai][m]);
#pragma unroll
                for (int bj = 0; bj < 2; ++bj) {
                    const f32x4 v0 = acc[ai][bj][m][0] * r, v1 = acc[ai][bj][m][1] * r;
                    u32x4 w; w.x = cvt_pk_bf16(v0[0], v0[1]); w.y = cvt_pk_bf16(v0[2], v0[3]); w.z = cvt_pk_bf16(v1[0], v1[1]); w.w = cvt_pk_bf16(v1[2], v1[3]);
                    bf16_t* dst;
                    if (u.pn < 8) { const int which = u.pn >> 2, head = (u.pn & 3) * 2 + bj, b = row >> 12, t = row & 4095;
                        dst = QK + (size_t)which * QK_STRIDE + ((size_t)((b * 8 + head) * 4096 + t)) * 128 + cin; }
                    else dst = G + (size_t)row * NGRP + (u.pn - 8) * 256 + bj * 128 + cin;
                    *(u32x4*)dst = w;
                }
            }
    }
};
struct EpiCol {
    static constexpr bool PERM = true, AFTER_DRAIN = false, RESID_DMA = false;
    bf16_t* O; int ldc; const float* ssq;
    __device__ __forceinline__ void operator()(const f32x4 (&acc)[2][2][4][2], const pg8::Unit& u, int wr, int wc, int fr, int fq) const {
        const int row0 = u.pm * 256 + wr * 64 + fr, col0 = u.pn * 256 + wc * 32 + 8 * fq;
        f32x4 cs[2][2];
#pragma unroll
        for (int bj = 0; bj < 2; ++bj)
#pragma unroll
            for (int n = 0; n < 2; ++n) {
                if (ssq) { const f32x4 q = *(const f32x4*)(ssq + col0 + bj * 128 + 4 * n); cs[bj][n] = (f32x4){rs_of(q[0]), rs_of(q[1]), rs_of(q[2]), rs_of(q[3])}; }
                else cs[bj][n] = (f32x4){1.f, 1.f, 1.f, 1.f};
            }
#pragma unroll
        for (int ai = 0; ai < 2; ++ai)
#pragma unroll
            for (int m = 0; m < 4; ++m) {
                const int row = row0 + ai * 128 + m * 16;
#pragma unroll
                for (int bj = 0; bj < 2; ++bj) {
                    const f32x4 v0 = acc[ai][bj][m][0] * cs[bj][0], v1 = acc[ai][bj][m][1] * cs[bj][1];
                    u32x4 w; w.x = cvt_pk_bf16(v0[0], v0[1]); w.y = cvt_pk_bf16(v0[2], v0[3]); w.z = cvt_pk_bf16(v1[0], v1[1]); w.w = cvt_pk_bf16(v1[2], v1[3]);
                    *(u32x4*)(O + (size_t)row * ldc + col0 + bj * 128) = w;
                }
            }
    }
};
struct EpiPleNorm {
    static constexpr bool PERM = true, AFTER_DRAIN = false, RESID_DMA = false;
    const bf16_t* H; float* OUT; const bf16_t* PROJ; const float* ssq3; float* ssq4; unsigned* cnt; const float* gfin; float mul;
    __device__ __forceinline__ void operator()(f32x4 (&acc)[2][2][4][2], const pg8::Unit& u, int wr, int wc, int fr, int fq) const {
        const int row0 = u.pm * 256 + wr * 64 + fr, col0 = u.pn * 256 + wc * 32 + 8 * fq;
#pragma unroll
        for (int ai = 0; ai < 2; ++ai)
#pragma unroll
            for (int m = 0; m < 4; ++m) {
                const int row = row0 + ai * 128 + m * 16; const float r = rs_of(ssq3[row]) * mul; float s = 0.f;
#pragma unroll
                for (int bj = 0; bj < 2; ++bj) {
                    const size_t off = (size_t)row * DM + col0 + bj * 128;
                    const v4u hq = *(const v4u*)(H + off);
                    const f32x4 h0 = (f32x4){bf_lo(hq.x), bf_hi(hq.x), bf_lo(hq.y), bf_hi(hq.y)}, h1 = (f32x4){bf_lo(hq.z), bf_hi(hq.z), bf_lo(hq.w), bf_hi(hq.w)};
                    const v4u pr = __builtin_nontemporal_load((const v4u*)(PROJ + off));
                    const f32x4 p0 = (f32x4){bf_lo(pr.x), bf_hi(pr.x), bf_lo(pr.y), bf_hi(pr.y)}, p1 = (f32x4){bf_lo(pr.z), bf_hi(pr.z), bf_lo(pr.w), bf_hi(pr.w)};
                    const f32x4 a0 = acc[ai][bj][m][0] * r, a1 = acc[ai][bj][m][1] * r;
                    f32x4 v0, v1;
#pragma unroll
                    for (int e = 0; e < 4; ++e) { v0[e] = h0[e] + sigmoid_f(a0[e]) * p0[e]; v1[e] = h1[e] + sigmoid_f(a1[e]) * p1[e]; }
                    acc[ai][bj][m][0] = v0; acc[ai][bj][m][1] = v1;
                    s += (v0[0] * v0[0] + v0[1] * v0[1]) + (v0[2] * v0[2] + v0[3] * v0[3]) + (v1[0] * v1[0] + v1[1] * v1[1]) + (v1[2] * v1[2] + v1[3] * v1[3]);
                }
                s += __shfl_xor(s, 16); s += __shfl_xor(s, 32);
                if (fq == 0) unsafeAtomicAdd(ssq4 + row, s);
            }
        asm volatile("s_waitcnt vmcnt(0)" ::: "memory");
        unsigned* cw = cnt + 64 * u.pm;
        if (fr == 0 && fq == 0) __hip_atomic_fetch_add(cw, 1u, __ATOMIC_RELAXED, __HIP_MEMORY_SCOPE_AGENT);
        f32x4 gf[2][2];
#pragma unroll
        for (int bj = 0; bj < 2; ++bj) { gf[bj][0] = *(const f32x4*)(gfin + col0 + bj * 128); gf[bj][1] = *(const f32x4*)(gfin + col0 + bj * 128 + 4); }
        { unsigned sp = 0; while ((unsigned)__builtin_amdgcn_readfirstlane((int)__hip_atomic_load(cw, __ATOMIC_RELAXED, __HIP_MEMORY_SCOPE_AGENT)) < 64u) { __builtin_amdgcn_s_sleep(2); if (++sp > (1u << 22)) break; } }
        asm volatile("" ::: "memory");
        float sq4[2][4];
#pragma unroll
        for (int ai = 0; ai < 2; ++ai)
#pragma unroll
            for (int m = 0; m < 4; ++m) sq4[ai][m] = __hip_atomic_load(ssq4 + row0 + ai * 128 + m * 16, __ATOMIC_RELAXED, __HIP_MEMORY_SCOPE_AGENT);
#pragma unroll
        for (int ai = 0; ai < 2; ++ai)
#pragma unroll
            for (int m = 0; m < 4; ++m) {
                const int row = row0 + ai * 128 + m * 16;
                const float r4 = rs_of(sq4[ai][m]);
#pragma unroll
                for (int bj = 0; bj < 2; ++bj) {
                    const size_t off = (size_t)row * DM + col0 + bj * 128;
                    *(f32x4*)(OUT + off) = acc[ai][bj][m][0] * r4 * gf[bj][0]; *(f32x4*)(OUT + off + 4) = acc[ai][bj][m][1] * r4 * gf[bj][1];
                }
            }
    }
};

struct Args { const float* in[22]; float* out; unsigned char* ws; };
struct TrDesc { const float* src; const float* gk; bf16_t* dst; int N, K, f8; };
struct TwDesc { const float* src; const float* gk; unsigned char* dst; int N, K, f8, gu; };
constexpr int TW_GU = 16 * 22, TW_WD = 44 * 8, TW_IN = 16 * 24, TW_SQ = 16 * 8, TW_PL = 2 * 8;
constexpr int TW_END_A = 4 * TW_GU, TW_END_B = TW_END_A + TW_SQ + TW_PL + TW_WD + TW_IN, TW_NITEMS = TW_END_B + TW_WD + TW_SQ;
__device__ __forceinline__ void tw_decode(const Args& a, unsigned char* ws, int it, TwDesc& d) {
    int r = it; const float* W; const float* gk = nullptr; size_t wt; int N, K, kb, nb, drow, f8 = 0, gu = 0;
    if (r < TW_END_A) {
        const int which = r / TW_GU; r -= which * TW_GU;
        kb = r / 22; nb = r % 22; N = FF; K = DM; gu = 1;
        W = a.in[which == 0 ? 3 : which == 1 ? 4 : which == 2 ? 15 : 16]; gk = a.in[which < 2 ? 2 : 14];
        wt = which < 2 ? WS_WGU1 : WS_WGU2; drow = nb * 512 + (which & 1) * 128; f8 = which >> 1;
    } else if (r < TW_END_B) {
        r -= TW_END_A;
        if (r < TW_SQ) { kb = r / 8; nb = r % 8; N = DM; K = DM; W = a.in[13]; wt = WS_WOUT; drow = nb * 256; }
        else if ((r -= TW_SQ) < TW_PL) { kb = r / 8; nb = r % 8; N = DM; K = PLE; W = a.in[20]; wt = WS_WPLE; drow = nb * 256; }
        else if ((r -= TW_PL) < TW_WD) { kb = r / 8; nb = r % 8; N = DM; K = FF; W = a.in[5]; wt = WS_WD1; drow = nb * 256; }
        else { r -= TW_WD; kb = r / 24; nb = r % 24; N = 6144; K = DM; W = a.in[7]; gk = a.in[6]; const int n0 = nb * 256;
            wt = WS_WIN; drow = n0;
            if (n0 >= 3072) drow = n0 - 1024; else if (n0 >= 2048) { wt = WS_WINV; drow = n0 - 2048; } }
    } else {
        r -= TW_END_B;
        if (r < TW_WD) { kb = r / 8; nb = r % 8; N = DM; K = FF; W = a.in[17]; wt = WS_WD2; drow = nb * 256; f8 = 1; }
        else { r -= TW_WD; kb = r / 8; nb = r % 8; N = DM; K = DM; W = a.in[19]; gk = a.in[18]; wt = WS_WGATE; drow = nb * 256; }
    }
    const int k0 = kb * 128, n0 = nb * 256;
    d.src = W + (size_t)k0 * N + n0; d.gk = gk ? gk + k0 : nullptr; d.N = N; d.K = K; d.f8 = f8; d.gu = gu;
    d.dst = ws + wt + ((size_t)drow * K + k0) * (f8 ? 1 : 2);
}
__device__ __forceinline__ void tw_range(const Args& a, unsigned char* ws, LAS unsigned char* lds, int wave, int lane, int lo, int hi, int w, int nw) {
    LAS float* img = (LAS float*)lds;
    f32x4 v[16]; TwDesc cur; int it = lo + w;
    if (it < hi) { tw_decode(a, ws, it, cur);
#pragma unroll
        for (int j = 0; j < 16; ++j) v[j] = __builtin_nontemporal_load((const f32x4*)(cur.src + (size_t)(wave * 16 + j) * cur.N + lane * 4)); }
    const int tid = wave * 64 + lane;
    while (it < hi) {
        __syncthreads();
#pragma unroll
        for (int j = 0; j < 16; ++j) { const int k = wave * 16 + j; const float g = cur.gk ? cur.gk[k] : 1.0f;
            *(LAS f32x4*)(img + k * 256 + ((lane * 4) ^ (((k >> 3) & 15) << 2))) = v[j] * g; }
        const int itn = it + nw; TwDesc nxt = cur;
        if (itn < hi) { tw_decode(a, ws, itn, nxt);
#pragma unroll
            for (int j = 0; j < 16; ++j) v[j] = __builtin_nontemporal_load((const f32x4*)(nxt.src + (size_t)(wave * 16 + j) * nxt.N + lane * 4)); }
        __syncthreads();
#pragma unroll
        for (int q8 = 0; q8 < 8; ++q8) { const int q = tid + 512 * q8, c = q & 15, n = q >> 4;
            const LAS float* sp = img + (8 * c) * 256 + (n ^ (c << 2));
            const float s0 = sp[0], s1 = sp[256], s2 = sp[512], s3 = sp[768], s4 = sp[1024], s5 = sp[1280], s6 = sp[1536], s7 = sp[1792];
            const size_t row = (size_t)(n + (cur.gu ? (n >> 7) * 128 : 0));
            if (cur.f8) {
                int w0 = __builtin_amdgcn_cvt_pk_fp8_f32(f8_clamp(s0 * WD_SCALE), f8_clamp(s1 * WD_SCALE), 0, false); w0 = __builtin_amdgcn_cvt_pk_fp8_f32(f8_clamp(s2 * WD_SCALE), f8_clamp(s3 * WD_SCALE), w0, true);
                int w1 = __builtin_amdgcn_cvt_pk_fp8_f32(f8_clamp(s4 * WD_SCALE), f8_clamp(s5 * WD_SCALE), 0, false); w1 = __builtin_amdgcn_cvt_pk_fp8_f32(f8_clamp(s6 * WD_SCALE), f8_clamp(s7 * WD_SCALE), w1, true);
                v2u o; o.x = (unsigned)w0; o.y = (unsigned)w1;
                *(v2u*)(cur.dst + row * cur.K + 8 * c) = o;
            } else {
                v4u o; o.x = cvt_pk_bf16(s0, s1); o.y = cvt_pk_bf16(s2, s3); o.z = cvt_pk_bf16(s4, s5); o.w = cvt_pk_bf16(s6, s7);
                *(v4u*)(cur.dst + (row * cur.K + 8 * c) * 2) = o; } }
        cur = nxt; it = itn;
    }
    __syncthreads();
}
__device__ __forceinline__ void tr_idle(const Args& a, unsigned char* ws, LAS unsigned char* lds, int wave, int bid, int G, int nwg, int lo, int hi) {
    const int rem = nwg % G, first = rem, nblk = G - rem;
    if (bid >= first) tw_range(a, ws, lds, wave, pg8::lane_id_v(), lo, hi, bid - first, nblk);
}
__device__ __forceinline__ void conv_ldx(const bf16_t* Grow, int ch, bool valid, float (&x)[8]) {
    if (valid) { const v4u a = __builtin_nontemporal_load((const v4u*)(Grow + 1024 + ch)), b = __builtin_nontemporal_load((const v4u*)(Grow + 2048 + ch));
        x[0] = bf_lo(a.x) * bf_lo(b.x); x[1] = bf_hi(a.x) * bf_hi(b.x); x[2] = bf_lo(a.y) * bf_lo(b.y); x[3] = bf_hi(a.y) * bf_hi(b.y);
        x[4] = bf_lo(a.z) * bf_lo(b.z); x[5] = bf_hi(a.z) * bf_hi(b.z); x[6] = bf_lo(a.w) * bf_lo(b.w); x[7] = bf_hi(a.w) * bf_hi(b.w); }
    else {
#pragma unroll
        for (int e = 0; e < 8; ++e) x[e] = 0.f; }
}

__global__ void __launch_bounds__(512, 2) mk_fwd(Args a) {
    extern __shared__ __attribute__((aligned(16))) unsigned char lds_raw[];
    LAS unsigned char* lds = (LAS unsigned char*)lds_raw;
    cg::grid_group grid = cg::this_grid();
    const int wave = __builtin_amdgcn_readfirstlane((int)threadIdx.x >> 6);
#define LANE_TID() const int lane = pg8::lane_id_v(), tid = wave * 64 + lane; (void)tid
    const int G = gridDim.x, bid = blockIdx.x, gw = bid * 8 + wave, NGW = G * 8;
    unsigned char* ws = a.ws;
    const float* x = a.in[0]; float* out = a.out;
    float* ssq0 = (float*)(ws + WS_SSQ); float* ssq1 = ssq0 + MTOK; float* ssq2 = ssq1 + MTOK; float* ssq3 = ssq2 + MTOK; float* ssq4 = ssq3 + MTOK;
    bf16_t* WGU1 = (bf16_t*)(ws + WS_WGU1); bf16_t* WD1 = (bf16_t*)(ws + WS_WD1); bf16_t* WIN = (bf16_t*)(ws + WS_WIN); bf16_t* WINV = (bf16_t*)(ws + WS_WINV);
    bf16_t* WOUT = (bf16_t*)(ws + WS_WOUT); bf16_t* WGU2 = (bf16_t*)(ws + WS_WGU2); bf16_t* WD2 = (bf16_t*)(ws + WS_WD2); bf16_t* WGATE = (bf16_t*)(ws + WS_WGATE);
    bf16_t* WPLE = (bf16_t*)(ws + WS_WPLE); bf16_t* HB = (bf16_t*)(ws + WS_HB); bf16_t* PB = (bf16_t*)(ws + WS_PB); unsigned char* ACT = ws + WS_ACT;
    bf16_t* QK = (bf16_t*)(ws + WS_QK); bf16_t* VT = (bf16_t*)(ws + WS_VT); bf16_t* MIX = (bf16_t*)(ws + WS_MIX); bf16_t* GB = (bf16_t*)(ws + WS_G); bf16_t* PROJ = (bf16_t*)(ws + WS_PROJ);

    unsigned* barw = (unsigned*)(ws + WS_BAR); unsigned* pcnt = (unsigned*)(ssq4 + MTOK);
    volatile LAS unsigned* MISC = (volatile LAS unsigned*)(lds + LDS_MISC);
    { LANE_TID(); if (tid < 2) MISC[tid] = 0u; }
    const XcdBarrier bar = xcd_barrier_post(barw, MISC, wave == 0 && pg8::lane_id_v() == 0);
    if (gridDim.y == 0x7fffu) grid.sync();
    {
        LANE_TID();
        for (int i = bid * 512 + tid; i < 4 * MTOK + 32 * 64; i += G * 512) ssq1[i] = 0.f;
        for (int row = gw; row < MTOK; row += NGW) {
            const f32x4* xr = (const f32x4*)(x + (size_t)row * DM) + lane;
            f32x4 v[8]; float s = 0.f;
#pragma unroll
            for (int j = 0; j < 8; ++j) { v[j] = __builtin_nontemporal_load(xr + 64 * j); s += (v[j][0] * v[j][0] + v[j][1] * v[j][1]) + (v[j][2] * v[j][2] + v[j][3] * v[j][3]); }
            s = wave_sum(s);
            if (lane == 0) ssq0[row] = s;
            v2u* o = (v2u*)(HB + (size_t)row * DM) + lane;
#pragma unroll
            for (int j = 0; j < 8; ++j) { v2u w; w.x = cvt_pk_bf16(v[j][0], v[j][1]); w.y = cvt_pk_bf16(v[j][2], v[j][3]); o[64 * j] = w; }
            const f32x4 pv = __builtin_nontemporal_load((const f32x4*)(a.in[1] + (size_t)row * PLE) + lane);
            v2u pw; pw.x = cvt_pk_bf16(pv[0], pv[1]); pw.y = cvt_pk_bf16(pv[2], pv[3]);
            ((v2u*)(PB + (size_t)row * PLE))[lane] = pw;
        }
        tw_range(a, ws, lds, wave, lane, 0, 2 * TW_GU, bid, G);
    }
    xcd_barrier(bar, wave == 0 && pg8::lane_id_v() == 0);
    { pg8::Gemm g{HB, WGU1, MTOK, 2 * FF, DM}; pg8::StaticOrder S; S.init(MTOK, 2 * FF, G, bid); EpiSwiGLU<false> E{ACT, ssq0, 1.0f};
      pg8::gemm_phase<EpiSwiGLU<false>, pg8::StaticOrder, true, true>(lds, g, S, E, wave); }
    tr_idle(a, ws, lds, wave, bid, G, (MTOK / 256) * (2 * FF / 256), TW_END_A, TW_END_B);
    xcd_barrier(bar, wave == 0 && pg8::lane_id_v() == 0);
    { pg8::Gemm g{(const bf16_t*)ACT, WD1, MTOK, DM, FF}; pg8::StaticOrder S; S.init(MTOK, DM, G, bid); EpiResidL<false> E{HB, nullptr, ssq1, 0.5f};
      pg8::gemm_phase<EpiResidL<false>, pg8::StaticOrder, true, true, false>(lds, g, S, E, wave); }
    xcd_barrier(bar, wave == 0 && pg8::lane_id_v() == 0);
    { pg8::Gemm g{HB, WIN, MTOK, 5120, DM}; pg8::StaticOrder S; S.init(MTOK, 5120, G, bid); EpiWin E{QK, GB, ssq1};
      pg8::gemm_phase<EpiWin, pg8::StaticOrder, true, true>(lds, g, S, E, wave); }
    { pg8::Gemm g{WINV, HB, 1024, MTOK, DM}; pg8::StaticOrder S; S.init(1024, MTOK, G, (bid + G / 2) % G); EpiCol E{VT, MTOK, ssq1};
      pg8::gemm_phase<EpiCol, pg8::StaticOrder, true, true>(lds, g, S, E, wave); }
    xcd_barrier(bar, wave == 0 && pg8::lane_id_v() == 0);
    {
        LANE_TID();
        float rpv[8];
#pragma unroll
        for (int k = 0; k < 8; ++k) { const int idx = tid + 512 * k; rpv[k] = idx < 8 * 15 * 31 ? a.in[8][idx] : 0.f; }
        tw_range(a, ws, lds, wave, lane, 2 * TW_GU, 4 * TW_GU, bid, G);
        LAS float* rpb_l = (LAS float*)lds;
        LAS unsigned char* ring = lds + 15360;
        constexpr int SLOT = 18432;
#pragma unroll
        for (int k = 0; k < 8; ++k) { const int idx = tid + 512 * k; if (idx < 8 * 15 * 31) rpb_l[idx] = rpv[k]; }
        __syncthreads();
        const bf16_t* QH = QK; const bf16_t* KH = QK + QK_STRIDE;
        const float* g_attn = a.in[11];
        const int j16 = lane & 15, kq = lane >> 4;
        const int kdst = (tid >> 4) * 272 + (tid & 15) * 16, vdst = (tid >> 3) * 144 + (tid & 7) * 16;
        for (int Wu = bid; Wu < 512; Wu += G) {
            const int xcd = Wu & 7, rp = (Wu >> 3) & 31, iter = Wu >> 8, bh = 2 * xcd + iter;
            const int r = 2 * rp + (wave >> 2), cb = wave & 3, b = bh >> 3, h = bh & 7;
            const int rsU = min(max(2 * rp - 4, 0), 56), rs = min(max(r - 4, 0), 56), dsh = rs - rsU, nU = min(max(2 * rp - 3, 0), 56) + 8 - rsU;
            const int kc0 = (cb == 0) ? 0 : (cb == 1) ? 8 : (cb == 2) ? 24 : 32;
            const size_t bhbase = (size_t)(b * 8 + h) * 4096;
            v4u kr[9][2];
            const unsigned char* Kg = (const unsigned char*)(KH + (bhbase + rsU * 64) * 128) + tid * 16;
#pragma unroll
            for (int j = 0; j < 9; ++j) if (j < nU) { kr[j][0] = *(const v4u*)(Kg + j * 16384); kr[j][1] = *(const v4u*)(Kg + j * 16384 + 8192); }
            const bf16_t* Qp = QH + (bhbase + r * 64 + cb * 16 + j16) * 128 + 8 * kq;
            bf16x8 qf[4];
#pragma unroll
            for (int ks = 0; ks < 4; ++ks) qf[ks] = *(const bf16x8*)(Qp + 32 * ks);
            *(LAS v4u*)(ring + kdst) = kr[0][0]; *(LAS v4u*)(ring + kdst + 32 * 272) = kr[0][1];
            asm volatile("s_waitcnt lgkmcnt(0)" ::: "memory"); __builtin_amdgcn_s_barrier(); asm volatile("" ::: "memory");
            const int koff = (kc0 + 8 * (j16 >> 2) + (j16 & 3)) * 272 + kq * 16;
            f32x4 sc[8][2];
#define ATT_S(I, BUF) do { bf16x8 k0_[4], k1_[4]; _Pragma("unroll") for (int ks = 0; ks < 4; ++ks) { k0_[ks] = *(const LAS bf16x8*)((BUF) + koff + ks * 64); k1_[ks] = *(const LAS bf16x8*)((BUF) + koff + 4 * 272 + ks * 64); } \
                f32x4 s0_ = (f32x4){0.f, 0.f, 0.f, 0.f}, s1_ = (f32x4){0.f, 0.f, 0.f, 0.f}; \
                _Pragma("unroll") for (int ks = 0; ks < 4; ++ks) { s0_ = __builtin_amdgcn_mfma_f32_16x16x32_bf16(k0_[ks], qf[ks], s0_, 0, 0, 0); s1_ = __builtin_amdgcn_mfma_f32_16x16x32_bf16(k1_[ks], qf[ks], s1_, 0, 0, 0); } \
                sc[I][0] = s0_; sc[I][1] = s1_; } while (0)
#pragma unroll
            for (int t = 0; t < 9; ++t) if (t < nU) {
                const LAS unsigned char* buf = ring + (t & 1) * SLOT;
                if (dsh == 0) { if (t < 8) ATT_S(t < 8 ? t : 0, buf); } else { if (t >= 1) ATT_S(t >= 1 ? t - 1 : 0, buf); }
                if (t + 1 < nU) { LAS unsigned char* nb = ring + ((t + 1) & 1) * SLOT; *(LAS v4u*)(nb + kdst) = kr[t + 1 < 9 ? t + 1 : 8][0]; *(LAS v4u*)(nb + kdst + 32 * 272) = kr[t + 1 < 9 ? t + 1 : 8][1]; }
                asm volatile("s_waitcnt lgkmcnt(0)" ::: "memory"); __builtin_amdgcn_s_barrier(); asm volatile("" ::: "memory");
            }
#undef ATT_S
            const unsigned char* Vg = (const unsigned char*)(VT + (size_t)(h * 128 + (tid >> 3)) * MTOK + b * 4096 + rsU * 64) + (tid & 7) * 16;
#pragma unroll
            for (int j = 0; j < 9; ++j) if (j < nU) { kr[j][0] = *(const v4u*)(Vg + j * 128); kr[j][1] = *(const v4u*)(Vg + j * 128 + (size_t)64 * MTOK * 2); }
            const int c = cb * 16 + j16, cs = min(max(c - 8, 0), 48);
            const float scale = 0.08838834764831845f;
            const LAS float* bl = rpb_l + h * 465 + (rs - r + 7) * 31;
            float mx = -3.0e38f;
#pragma unroll
            for (int i = 0; i < 8; ++i)
#pragma unroll
                for (int tl = 0; tl < 2; ++tl)
#pragma unroll
                    for (int t = 0; t < 4; ++t) {
                        const int kc = kc0 + 8 * kq + 4 * tl + t; const bool inw = (kc >= cs) && (kc < cs + 16);
                        const int rel = min(max(kc - c + 15, 0), 30);
                        float v = sc[i][tl][t] * scale + bl[i * 31 + rel]; v = inw ? v : -1e30f; sc[i][tl][t] = v; mx = fmaxf(mx, v);
                    }
            mx = fmaxf(mx, __shfl_xor(mx, 16)); mx = fmaxf(mx, __shfl_xor(mx, 32));
            float sum = 0.f;
#pragma unroll
            for (int i = 0; i < 8; ++i)
#pragma unroll
                for (int tl = 0; tl < 2; ++tl)
#pragma unroll
                    for (int t = 0; t < 4; ++t) { const float pe = __builtin_amdgcn_exp2f((sc[i][tl][t] - mx) * 1.4426950408889634f); sc[i][tl][t] = pe; sum += pe; }
            sum += __shfl_xor(sum, 16); sum += __shfl_xor(sum, 32);
            f32x4 oacc[8];
#pragma unroll
            for (int dt = 0; dt < 8; ++dt) oacc[dt] = (f32x4){0.f, 0.f, 0.f, 0.f};
            *(LAS v4u*)(ring + vdst) = kr[0][0]; *(LAS v4u*)(ring + vdst + 64 * 144) = kr[0][1];
            asm volatile("s_waitcnt lgkmcnt(0)" ::: "memory"); __builtin_amdgcn_s_barrier(); asm volatile("" ::: "memory");
            const int voff = j16 * 144 + (kc0 + 8 * kq) * 2;
#define ATT_PV(I, BUF) do { u32x4 pw_; pw_.x = cvt_pk_bf16(sc[I][0][0], sc[I][0][1]); pw_.y = cvt_pk_bf16(sc[I][0][2], sc[I][0][3]); pw_.z = cvt_pk_bf16(sc[I][1][0], sc[I][1][1]); pw_.w = cvt_pk_bf16(sc[I][1][2], sc[I][1][3]); \
                const bf16x8 pf_ = __builtin_bit_cast(bf16x8, pw_); \
                _Pragma("unroll") for (int dt = 0; dt < 8; ++dt) { const bf16x8 vf_ = *(const LAS bf16x8*)((BUF) + voff + dt * 16 * 144); oacc[dt] = __builtin_amdgcn_mfma_f32_16x16x32_bf16(vf_, pf_, oacc[dt], 0, 0, 0); } } while (0)
#pragma unroll
            for (int t = 0; t < 9; ++t) if (t < nU) {
                const LAS unsigned char* buf = ring + (t & 1) * SLOT;
                if (dsh == 0) { if (t < 8) ATT_PV(t < 8 ? t : 0, buf); } else { if (t >= 1) ATT_PV(t >= 1 ? t - 1 : 0, buf); }
                if (t + 1 < nU) { LAS unsigned char* nb = ring + ((t + 1) & 1) * SLOT; *(LAS v4u*)(nb + vdst) = kr[t + 1 < 9 ? t + 1 : 8][0]; *(LAS v4u*)(nb + vdst + 64 * 144) = kr[t + 1 < 9 ? t + 1 : 8][1]; }
                asm volatile("s_waitcnt lgkmcnt(0)" ::: "memory"); __builtin_amdgcn_s_barrier(); asm volatile("" ::: "memory");
            }
#undef ATT_PV
            const float inv = 1.f / sum; float ss = 0.f;
#pragma unroll
            for (int dt = 0; dt < 8; ++dt) { oacc[dt] = oacc[dt] * inv; ss += (oacc[dt][0] * oacc[dt][0] + oacc[dt][1] * oacc[dt][1]) + (oacc[dt][2] * oacc[dt][2] + oacc[dt][3] * oacc[dt][3]); }
            ss += __shfl_xor(ss, 16); ss += __shfl_xor(ss, 32);
            const float rn = rsqrtf(ss * (1.f / 128.f) + EPS);
            bf16_t* Op = MIX + (size_t)(b * 4096 + r * 64 + c) * DM + h * 128 + 4 * kq;
#pragma unroll
            for (int dt = 0; dt < 8; ++dt) { const f32x4 gn = *(const f32x4*)(g_attn + h * 128 + 16 * dt + 4 * kq); const f32x4 o = oacc[dt] * rn * gn;
                v2u w; w.x = cvt_pk_bf16(o[0], o[1]); w.y = cvt_pk_bf16(o[2], o[3]); *(v2u*)(Op + 16 * dt) = w; }
        }
        for (int it = gw; it < 2048; it += NGW) {
            const int half = it & 1, row0 = (it >> 1) * 8, ch = half * 512 + lane * 8;
            float w0[8], w1[8], w2[8], bb[8], gn[8];
#pragma unroll
            for (int q = 0; q < 2; ++q) {
                const f32x4 t0 = *(const f32x4*)(a.in[9] + ch + 4 * q), t1 = *(const f32x4*)(a.in[9] + 1024 + ch + 4 * q), t2 = *(const f32x4*)(a.in[9] + 2048 + ch + 4 * q);
                const f32x4 t3 = *(const f32x4*)(a.in[10] + ch + 4 * q), t4 = *(const f32x4*)(a.in[12] + ch + 4 * q);
#pragma unroll
                for (int e = 0; e < 4; ++e) { w0[4 * q + e] = t0[e]; w1[4 * q + e] = t1[e]; w2[4 * q + e] = t2[e]; bb[4 * q + e] = t3[e]; gn[4 * q + e] = t4[e]; }
            }
            const bf16_t* Gr = GB + (size_t)row0 * NGRP;
            float xp[8], xc[8], xn[8];
            conv_ldx(Gr - NGRP, ch, (row0 & 4095) != 0, xp);
            conv_ldx(Gr, ch, true, xc);
#pragma unroll
            for (int tk = 0; tk < 8; ++tk) {
                const int row = row0 + tk;
                conv_ldx(Gr + (size_t)(tk + 1) * NGRP, ch, (row & 4095) != 4095, xn);
                const v4u gbv = __builtin_nontemporal_load((const v4u*)(Gr + (size_t)tk * NGRP + ch));
                float gbf[8] = {bf_lo(gbv.x), bf_hi(gbv.x), bf_lo(gbv.y), bf_hi(gbv.y), bf_lo(gbv.z), bf_hi(gbv.z), bf_lo(gbv.w), bf_hi(gbv.w)};
                float y[8]; float ss = 0.f;
#pragma unroll
                for (int e = 0; e < 8; ++e) { y[e] = gbf[e] * (w0[e] * xp[e] + w1[e] * xc[e] + w2[e] * xn[e] + bb[e]); ss += y[e] * y[e]; }
                ss += __shfl_xor(ss, 1); ss += __shfl_xor(ss, 2); ss += __shfl_xor(ss, 4); ss += __shfl_xor(ss, 8);
                const float rn = rsqrtf(ss * (1.f / 128.f) + EPS);
                v4u w; w.x = cvt_pk_bf16(y[0] * rn * gn[0], y[1] * rn * gn[1]); w.y = cvt_pk_bf16(y[2] * rn * gn[2], y[3] * rn * gn[3]);
                w.z = cvt_pk_bf16(y[4] * rn * gn[4], y[5] * rn * gn[5]); w.w = cvt_pk_bf16(y[6] * rn * gn[6], y[7] * rn * gn[7]);
                *(v4u*)(MIX + (size_t)row * DM + 1024 + ch) = w;
#pragma unroll
                for (int e = 0; e < 8; ++e) { xp[e] = xc[e]; xc[e] = xn[e]; }
            }
        }
        __syncthreads();
    }
    xcd_barrier(bar, wave == 0 && pg8::lane_id_v() == 0);
    { pg8::Gemm g{MIX, WOUT, MTOK, DM, DM}; pg8::StaticOrder S; S.init(MTOK, DM, G, bid); EpiResidL<true> E{HB, ws + WS_HB8, ssq2, 1.0f};
      pg8::gemm_phase<EpiResidL<true>, pg8::StaticOrder, true, true>(lds, g, S, E, wave); }
    { pg8::Gemm g{PB, WPLE, MTOK, DM, PLE}; pg8::StaticOrder S; S.init(MTOK, DM, G, bid); EpiCol E{PROJ, DM, nullptr};
      pg8::gemm_phase<EpiCol, pg8::StaticOrder, true, true>(lds, g, S, E, wave); }
    xcd_barrier(bar, wave == 0 && pg8::lane_id_v() == 0);
    { pg8::Gemm g{(const bf16_t*)(ws + WS_HB8), WGU2, MTOK, 2 * FF, DM / 2}; pg8::StaticOrder S; S.init(MTOK, 2 * FF, G, bid); EpiSwiGLU<true> E{ACT, ssq2, 1.0f / (H_SCALE * WD_SCALE)};
      pg8::gemm_phase<EpiSwiGLU<true>, pg8::StaticOrder, true, true, true>(lds, g, S, E, wave); }
    tr_idle(a, ws, lds, wave, bid, G, (MTOK / 256) * (2 * FF / 256), TW_END_B, TW_NITEMS);
    xcd_barrier(bar, wave == 0 && pg8::lane_id_v() == 0);
    { pg8::Gemm g{(const bf16_t*)ACT, WD2, MTOK, DM, FF / 2}; pg8::StaticOrder S; S.init(MTOK, DM, G, bid); EpiResidL<false> E{HB, nullptr, ssq3, 0.5f / (ACT_SCALE * WD_SCALE)};
      pg8::gemm_phase<EpiResidL<false>, pg8::StaticOrder, true, true, true>(lds, g, S, E, wave); }
    xcd_barrier(bar, wave == 0 && pg8::lane_id_v() == 0);
    { pg8::Gemm g{HB, WGATE, MTOK, DM, DM}; pg8::StaticOrder S; S.init(MTOK, DM, G, bid); EpiPleNorm E{HB, out, PROJ, ssq3, ssq4, pcnt, a.in[21], 1.0f};
      pg8::gemm_phase<EpiPleNorm, pg8::StaticOrder, true, true, false>(lds, g, S, E, wave); }
}

extern "C" void kernel_launch(void* const* d_in, const int* in_sizes, int n_in, void* d_out, int out_size, void* d_ws, size_t ws_size, hipStream_t stream) {
    static int grid = 0;
    if (grid == 0) {
        if (n_in != 22 || out_size != MTOK * DM || ws_size < WS_END) { fprintf(stderr, "kernel_launch: unexpected shapes (n_in %d out %d ws %zu)\n", n_in, out_size, ws_size); grid = -1; return; }
        int dev = 0, cus = 0, per_cu = 0;
        (void)hipGetDevice(&dev);
        (void)hipDeviceGetAttribute(&cus, hipDeviceAttributeMultiprocessorCount, dev);
        (void)hipFuncSetAttribute((const void*)mk_fwd, hipFuncAttributeMaxDynamicSharedMemorySize, LDS_BYTES);
        (void)hipOccupancyMaxActiveBlocksPerMultiprocessor(&per_cu, (const void*)mk_fwd, 512, LDS_BYTES);
        (void)hipGetLastError();
        grid = cus > 0 ? cus : 256;
    }
    if (grid < 0) return;
    if (hipMemsetAsync((unsigned char*)d_ws + WS_BAR, 0, XCD_BAR_WORDS * 4, stream) != hipSuccess) { fprintf(stderr, "kernel_launch: memset of the barrier words failed\n"); return; }
    Args a{};
    for (int i = 0; i < 22; ++i) a.in[i] = (const float*)d_in[i];
    a.out = (float*)d_out; a.ws = (unsigned char*)d_ws;
    void* args[] = {&a};
    hipError_t e = hipLaunchCooperativeKernel((const void*)mk_fwd, dim3(grid), dim3(512), args, LDS_BYTES, stream);
    if (e != hipSuccess) fprintf(stderr, "cooperative launch failed: %s (grid %d)\n", hipGetErrorString(e), grid);
}
```
